# Optimizing an MI355X kernel written in HIP

```python
import jax, jax.numpy as jnp
from jax import lax
import numpy as np

D_MODEL = 2048
BATCH = 4
SEQ = 4096
DEPTH = 1

D_MIX = D_MODEL
RET_HEAD_DIM = 128
RET_HEADS = (D_MIX // 2) // RET_HEAD_DIM
RET_WIDTH = RET_HEADS * RET_HEAD_DIM
RET_CHUNK = 128
RET_THETA = 10000.0
RET_DECAY_BASE = 5
GN_EPS = 1e-5
ATT_HEAD_DIM = 128
ATT_HEADS = (D_MIX - RET_WIDTH) // ATT_HEAD_DIM
ATT_KV_HEADS = 2
ATT_WIDTH = ATT_HEADS * ATT_HEAD_DIM
ATT_KV_WIDTH = ATT_KV_HEADS * ATT_HEAD_DIM
WINDOW = 128
ATT_BLOCK = 128
ROPE_THETA = 500000.0
ROPE_DIMS = ATT_HEAD_DIM // 4
NORM_EPS = 1e-6
MASK_VALUE = -1e30
D_IN_PROJ = 4 * RET_WIDTH + 2 * ATT_WIDTH + 2 * ATT_KV_WIDTH

kernel_name = "hybrid_retention_window_gqa_block"


def rms_norm(x, w):
    xf = x.astype(jnp.float32)
    y = xf * lax.rsqrt(jnp.mean(xf * xf, axis=-1, keepdims=True) + NORM_EPS)
    return (y * w.astype(jnp.float32)).astype(x.dtype)


def rotary(x, rot_dims, theta):
    S = x.shape[1]
    half = rot_dims // 2
    inv_freq = theta ** (-jnp.arange(half, dtype=jnp.float32) / half)
    ang = jnp.arange(S, dtype=jnp.float32)[:, None] * inv_freq[None, :]
    cos = jnp.cos(ang)[None, :, None, :]
    sin = jnp.sin(ang)[None, :, None, :]
    xr = x[..., :rot_dims].astype(jnp.float32)
    x1, x2 = xr[..., :half], xr[..., half:]
    rot = jnp.concatenate([x1 * cos - x2 * sin, x2 * cos + x1 * sin], axis=-1).astype(x.dtype)
    return jnp.concatenate([rot, x[..., rot_dims:]], axis=-1)


def retention_chunkwise(q, k, v, log_gamma, include_diag):
    B, H, S, Dk = q.shape
    Dv = v.shape[-1]
    C = RET_CHUNK
    NC = S // C
    qc = q.reshape(B, H, NC, C, Dk)
    kc = k.reshape(B, H, NC, C, Dk)
    vc = v.reshape(B, H, NC, C, Dv)
    idx = jnp.arange(C, dtype=jnp.float32)
    diff = idx[:, None] - idx[None, :]
    mask = (diff >= 0) if include_diag else (diff > 0)
    decay = jnp.where(mask[None], jnp.exp(log_gamma[:, None, None] * jnp.where(mask, diff, 0.0)[None]), 0.0)
    scores = jnp.einsum('bhnik,bhnjk->bhnij', qc, kc) * decay[None, :, None]
    inner = jnp.einsum('bhnij,bhnjv->bhniv', scores, vc)
    k_dec = jnp.exp(log_gamma[:, None] * (C - 1 - idx)[None, :])
    kv_chunk = jnp.einsum('bhnjk,hj,bhnjv->nbhkv', kc, k_dec, vc)
    chunk_decay = jnp.exp(log_gamma * C)[None, :, None, None]

    def step(state, kv):
        return state * chunk_decay + kv, state

    _, prev = lax.scan(step, jnp.zeros((B, H, Dk, Dv), jnp.float32), kv_chunk)
    q_dec = jnp.exp(log_gamma[:, None] * (idx + 1.0)[None, :])
    cross = jnp.einsum('bhnik,hi,nbhkv->bhniv', qc, q_dec, prev)
    return (inner + cross).reshape(B, H, S, Dv)


def retention_branch(rq, rk, rv, decay_fwd, decay_bwd, gn_w, gn_b):
    B, S, _ = rq.shape
    q = rotary(rq.reshape(B, S, RET_HEADS, RET_HEAD_DIM), RET_HEAD_DIM, RET_THETA)
    k = rotary(rk.reshape(B, S, RET_HEADS, RET_HEAD_DIM), RET_HEAD_DIM, RET_THETA)
    q = q.astype(jnp.float32).transpose(0, 2, 1, 3)
    k = k.astype(jnp.float32).transpose(0, 2, 1, 3) * (RET_HEAD_DIM ** -0.5)
    v = rv.reshape(B, S, RET_HEADS, RET_HEAD_DIM).astype(jnp.float32).transpose(0, 2, 1, 3)
    lg_f = jax.nn.log_sigmoid(decay_fwd.astype(jnp.float32))
    lg_b = jax.nn.log_sigmoid(decay_bwd.astype(jnp.float32))
    y_f = retention_chunkwise(q, k, v, lg_f, True)
    y_b = retention_chunkwise(q[:, :, ::-1], k[:, :, ::-1], v[:, :, ::-1], lg_b, False)[:, :, ::-1]
    y = (y_f + y_b).transpose(0, 2, 1, 3)
    mu = jnp.mean(y, axis=-1, keepdims=True)
    var = jnp.mean(jnp.square(y - mu), axis=-1, keepdims=True)
    y = ((y - mu) * lax.rsqrt(var + GN_EPS)).reshape(B, S, RET_WIDTH)
    return y * gn_w.astype(jnp.float32) + gn_b.astype(jnp.float32)


def window_attention_branch(aq, ak, av, sink):
    B, S, _ = aq.shape
    T = ATT_BLOCK
    NB = S // T
    G = ATT_HEADS // ATT_KV_HEADS
    q = rotary(aq.reshape(B, S, ATT_HEADS, ATT_HEAD_DIM), ROPE_DIMS, ROPE_THETA)
    k = rotary(ak.reshape(B, S, ATT_KV_HEADS, ATT_HEAD_DIM), ROPE_DIMS, ROPE_THETA)
    v = av.reshape(B, S, ATT_KV_HEADS, ATT_HEAD_DIM)
    qb = q.reshape(B, NB, T, ATT_KV_HEADS, G, ATT_HEAD_DIM)
    pad = ((0, 0), (T, T), (0, 0), (0, 0))
    kp = jnp.pad(k, pad).reshape(B, NB + 2, T, ATT_KV_HEADS, ATT_HEAD_DIM)
    vp = jnp.pad(v, pad).reshape(B, NB + 2, T, ATT_KV_HEADS, ATT_HEAD_DIM)
    kw = jnp.concatenate([kp[:, :-2], kp[:, 1:-1], kp[:, 2:]], axis=2)
    vw = jnp.concatenate([vp[:, :-2], vp[:, 1:-1], vp[:, 2:]], axis=2)
    qpos = jnp.arange(S).reshape(NB, T)
    kpos_p = (jnp.arange(S + 2 * T) - T).reshape(NB + 2, T)
    kpos = jnp.concatenate([kpos_p[:-2], kpos_p[1:-1], kpos_p[2:]], axis=1)
    valid = (jnp.abs(qpos[:, :, None] - kpos[:, None, :]) <= WINDOW) & (kpos[:, None, :] >= 0) & (kpos[:, None, :] < S)
    s = jnp.einsum('bntkgd,bnskd->bnkgts', qb.astype(jnp.float32), kw.astype(jnp.float32)) * (ATT_HEAD_DIM ** -0.5)
    s = jnp.where(valid[None, :, None, None], s, MASK_VALUE)
    sink_l = sink.astype(jnp.float32).reshape(ATT_KV_HEADS, G)[None, None, :, :, None, None]
    m = jnp.maximum(jnp.max(s, axis=-1, keepdims=True), sink_l)
    p = jnp.exp(s - m)
    denom = jnp.sum(p, axis=-1, keepdims=True) + jnp.exp(sink_l - m)
    out = jnp.einsum('bnkgts,bnskd->bntkgd', p / denom, vw.astype(jnp.float32))
    return out.reshape(B, S, ATT_WIDTH)


def hybrid_layer(x, w_in, w_out, norm_w, decay_fwd, decay_bwd, gn_w, gn_b, sink):
    h = rms_norm(x, norm_w)
    proj = h @ w_in
    splits = [RET_WIDTH, 2 * RET_WIDTH, 3 * RET_WIDTH, 4 * RET_WIDTH,
              4 * RET_WIDTH + ATT_WIDTH, 4 * RET_WIDTH + ATT_WIDTH + ATT_KV_WIDTH,
              4 * RET_WIDTH + ATT_WIDTH + 2 * ATT_KV_WIDTH]
    rq, rk, rv, rg, aq, ak, av, ag = jnp.split(proj, splits, axis=-1)
    y_ret = retention_branch(rq, rk, rv, decay_fwd, decay_bwd, gn_w, gn_b) * jax.nn.silu(rg.astype(jnp.float32))
    y_att = window_attention_branch(aq, ak, av, sink) * jax.nn.silu(ag.astype(jnp.float32))
    y = jnp.concatenate([y_ret, y_att], axis=-1).astype(x.dtype)
    return x + y @ w_out


def setup_inputs(seed: int = 0) -> dict:
    key = jax.random.key(seed)
    ks = jax.random.split(key, 10)
    x = jax.random.normal(ks[0], (BATCH, SEQ, D_MODEL), jnp.float32)
    w_in = jax.random.normal(ks[1], (DEPTH, D_MODEL, D_IN_PROJ), jnp.float32) * (D_MODEL ** -0.5)
    w_out = jax.random.normal(ks[2], (DEPTH, D_MIX, D_MODEL), jnp.float32) * (D_MIX ** -0.5)
    norm_w = 1.0 + 0.01 * jax.random.normal(ks[3], (DEPTH, D_MODEL), jnp.float32)
    exps = RET_DECAY_BASE + jnp.arange(RET_HEADS, dtype=jnp.float32)
    base_logit = jnp.log(2.0 ** exps - 1.0)
    decay_fwd = base_logit[None] + 0.01 * jax.random.normal(ks[4], (DEPTH, RET_HEADS), jnp.float32)
    decay_bwd = base_logit[None] + 0.01 * jax.random.normal(ks[5], (DEPTH, RET_HEADS), jnp.float32)
    gn_w = 1.0 + 0.01 * jax.random.normal(ks[6], (DEPTH, RET_WIDTH), jnp.float32)
    gn_b = 0.01 * jax.random.normal(ks[7], (DEPTH, RET_WIDTH), jnp.float32)
    sink = jax.random.normal(ks[8], (DEPTH, ATT_HEADS), jnp.float32)
    final_norm_w = 1.0 + 0.01 * jax.random.normal(ks[9], (D_MODEL,), jnp.float32)
    return {"x": x, "w_in": w_in, "w_out": w_out, "norm_w": norm_w,
            "decay_fwd": decay_fwd, "decay_bwd": decay_bwd, "gn_w": gn_w, "gn_b": gn_b,
            "sink": sink, "final_norm_w": final_norm_w}


def reference(x, w_in, w_out, norm_w, decay_fwd, decay_bwd, gn_w, gn_b, sink, final_norm_w):
    for l in range(DEPTH):
        x = hybrid_layer(x, w_in[l], w_out[l], norm_w[l], decay_fwd[l], decay_bwd[l], gn_w[l], gn_b[l], sink[l])
    return rms_norm(x, final_norm_w)
```

```cpp
#include <hip/hip_runtime.h>
#include <hip/hip_cooperative_groups.h>
#include <cstdio>
#include <cstdint>
namespace cg = cooperative_groups;

#define LAS __attribute__((address_space(3)))
typedef unsigned short bf16_t;
typedef short bf16x8 __attribute__((ext_vector_type(8)));
typedef short s16x4 __attribute__((ext_vector_type(4)));
typedef float f32x4 __attribute__((ext_vector_type(4)));
typedef unsigned u32x4 __attribute__((ext_vector_type(4)));
typedef unsigned u32x2 __attribute__((ext_vector_type(2)));

constexpr int NB_ = 4, SEQ = 4096, DM = 2048, MTOK = NB_ * SEQ;
constexpr int NP = 6656;
constexpr int C_RQ = 0, C_RK = 1024, C_RV = 2048, C_RG = 3072, C_AQ = 4096, C_AK = 5120, C_AV = 5376, C_AG = 5632;
constexpr int NCH = 32;
constexpr float QK_SCALE = 0.08838834764831845f;
constexpr float LOG2E = 1.4426950408889634f;

constexpr size_t MiB = 1u << 20;
constexpr size_t WS_CTL = 0;
constexpr size_t WS_COSR = 1 * MiB, WS_SINR = 2 * MiB, WS_COSA = 3 * MiB, WS_SINA = 3 * MiB + 512 * 1024;
constexpr size_t WS_RSTD = 4 * MiB;
constexpr size_t WS_WIN = 8 * MiB;
constexpr size_t WS_WOUT = 34 * MiB;
constexpr size_t WS_XB = 48 * MiB;
constexpr size_t WS_PROJ = 112 * MiB;
constexpr size_t WS_STATE = 320 * MiB;
constexpr size_t WS_Y = 384 * MiB;
constexpr size_t WS_END = 448 * MiB;

namespace pg8 {
constexpr int BM = 256, BK = 64, HALF = 128, HTB = HALF * BK * 2, STAGE_BYTES = 8 * HTB, NXCD = 8, WGM = 8;
__host__ __device__ __forceinline__ int lds_byte(int r, int c) { const int st = (r >> 4) * 2 + (c >> 5), rr = r & 15, cc = c & 31, ob = rr * 64 + cc * 2; return st * 1024 + (ob ^ (((ob >> 9) & 1) << 5)); }
__host__ __device__ __forceinline__ void stage_rc(int b, int& R, int& C) { const int st = b / 1024, sb = b % 1024, swz = sb ^ (((sb >> 9) & 1) << 5); R = (st >> 1) * 16 + swz / 64; C = (st & 1) * 32 + (swz % 64) / 2; }
__host__ __device__ __forceinline__ int perm32(int rho) { const int n = rho >> 4, i = rho & 15; return 8 * (i >> 2) + 4 * n + (i & 3); }
struct Unit { int pm, pn; };
struct Gemm { const bf16_t* A; const bf16_t* Bt; int M, N, K; };
struct StaticOrder {
    int nM, nN, nwg, G, c;
    __host__ __device__ void init(int M, int N, int G_, int c_) { nM = M / BM; nN = N / BM; nwg = nM * nN; G = G_; c = c_; }
    __host__ __device__ bool next(int i, Unit& u) const {
        const long L = (long)i * G + c; if (L >= nwg) return false;
        int wgid = (int)L; { const int q = nwg / NXCD, r = nwg % NXCD, xcd = wgid % NXCD, off = wgid / NXCD; wgid = (xcd < r ? xcd * (q + 1) : r * (q + 1) + (xcd - r) * q) + off; }
        const int nig = WGM * nN, gid = wgid / nig, fm = gid * WGM, gsz = (nM - fm) < WGM ? (nM - fm) : WGM;
        u.pm = fm + ((wgid % nig) % gsz); u.pn = (wgid % nig) / gsz; return true;
    }
    __device__ __forceinline__ void a_ready(const Unit&) const {}
    __device__ __forceinline__ void done(const Unit&) const {}
};
__device__ __forceinline__ unsigned cvt_pk_bf16(float lo, float hi) { unsigned r; asm volatile("v_cvt_pk_bf16_f32 %0, %1, %2" : "=v"(r) : "v"(lo), "v"(hi)); return r; }

struct EpiProj {
    static constexpr bool PERM = true, AFTER_DRAIN = false;
    bf16_t* O; int ldc; const float* rstd;
    __device__ __forceinline__ void operator()(const f32x4 (&acc)[2][2][4][2], const Unit& u, int wr, int wc, int fr, int fq) const {
        const int row0 = u.pm * BM + wr * 64 + fr; const int col0 = u.pn * BM + wc * 32 + 8 * fq;
#pragma unroll
        for (int ai = 0; ai < 2; ++ai)
#pragma unroll
            for (int m = 0; m < 4; ++m) { const int row = row0 + ai * HALF + m * 16; const float s = rstd[row]; bf16_t* rowp = O + (size_t)row * ldc + col0;
#pragma unroll
                for (int bj = 0; bj < 2; ++bj) { const f32x4 v0 = acc[ai][bj][m][0] * s, v1 = acc[ai][bj][m][1] * s;
                    u32x4 w; w.x = cvt_pk_bf16(v0[0], v0[1]); w.y = cvt_pk_bf16(v0[2], v0[3]); w.z = cvt_pk_bf16(v1[0], v1[1]); w.w = cvt_pk_bf16(v1[2], v1[3]);
                    *(u32x4*)(rowp + bj * HALF) = w; } }
    }
};
struct EpiRes {
    static constexpr bool PERM = false, AFTER_DRAIN = false;
    const float* base; float* out; int ldc;
    __device__ __forceinline__ void operator()(const f32x4 (&acc)[2][2][4][2], const Unit& u, int wr, int wc, int fr, int fq) const {
        const int col0 = u.pn * BM + wc * 32 + 4 * fq;
#pragma unroll
        for (int ai = 0; ai < 2; ++ai)
#pragma unroll
            for (int m = 0; m < 4; ++m) { const size_t off = (size_t)(u.pm * BM + ai * HALF + wr * 64 + m * 16 + fr) * ldc + col0;
#pragma unroll
                for (int bj = 0; bj < 2; ++bj)
#pragma unroll
                    for (int n = 0; n < 2; ++n) { const f32x4 bs = *(const f32x4*)(base + off + bj * HALF + n * 16); *(f32x4*)(out + off + bj * HALF + n * 16) = bs + acc[ai][bj][m][n]; } }
    }
};

template <class Epi, class Sched, bool ALIGN_EPI = false, bool SP2 = false>
__device__ __forceinline__ void gemm_phase(LAS unsigned char* lds, const Gemm g, const Sched& S, const Epi& E) {
    int tid = threadIdx.x; asm volatile("" : "+v"(tid));
    const int wid = __builtin_amdgcn_readfirstlane(tid >> 6), lane = tid & 63, wr = wid >> 2, wc = wid & 3, fr = lane & 15, fq = lane >> 4;
    const int K = g.K, nt = K / BK;
    unsigned voffA[2], voffB[2];
#pragma unroll
    for (int i = 0; i < 2; ++i) { int R, C; stage_rc(tid * 16 + i * 8192, R, C); const int Rb = Epi::PERM ? ((R & ~31) + perm32(R & 31)) : R;
        voffA[i] = (unsigned)(R * K + C) * 2u; voffB[i] = (unsigned)(Rb * K + C) * 2u; }
    const size_t kstep = (size_t)(BK * 2);
    const size_t hstep = (size_t)HALF * K * 2;
    const size_t tstep = 2 * hstep;
    const unsigned ldsw = (unsigned)wid * 1024u;
    const int aoff = lds_byte(wr * 64 + fr, fq * 8), boff = lds_byte(wc * 32 + fr, fq * 8);
#define PG8_SA(b, h) (((b) * 2 + (h)) * HTB)
#define PG8_SB(b, h) ((4 + (b) * 2 + (h)) * HTB)
#define PG8_STAGE(bufoff, gbase, voff) do { _Pragma("unroll") for (int _i = 0; _i < 2; ++_i) \
        __builtin_amdgcn_global_load_lds((const unsigned*)((const char*)(gbase) + (voff)[_i]), (LAS unsigned*)(lds + (bufoff) + ldsw + _i * 8192), 16, 0, 0); } while (0)
#define PG8_LDA(dst, b, h) do { _Pragma("unroll") for (int m = 0; m < 4; ++m) _Pragma("unroll") for (int k = 0; k < 2; ++k) dst[m][k] = *(const LAS bf16x8*)(lds + PG8_SA(b, h) + aoff + m * 2048 + k * 1024); } while (0)
#define PG8_LDB(dst, b, h) do { _Pragma("unroll") for (int n = 0; n < 2; ++n) _Pragma("unroll") for (int k = 0; k < 2; ++k) dst[n][k] = *(const LAS bf16x8*)(lds + PG8_SB(b, h) + boff + n * 2048 + k * 1024); } while (0)
#define PG8_MMA(ai, bj, At, Bt) do { __builtin_amdgcn_s_setprio(1); _Pragma("unroll") for (int m = 0; m < 4; ++m) _Pragma("unroll") for (int n = 0; n < 2; ++n) _Pragma("unroll") for (int k = 0; k < 2; ++k) \
        acc[ai][bj][m][n] = __builtin_amdgcn_mfma_f32_16x16x32_bf16(Bt[n][k], At[m][k], acc[ai][bj][m][n], 0, 0, 0); __builtin_amdgcn_s_setprio(0); } while (0)
#define PG8_WAIT_V(n) asm volatile("s_waitcnt vmcnt(" #n ")" ::: "memory")
#define PG8_WAIT_L(n) asm volatile("s_waitcnt lgkmcnt(" #n ")" ::: "memory")
#define PG8_BAR __builtin_amdgcn_s_barrier()
#define PG8_SCHED __builtin_amdgcn_sched_barrier(0)
    Unit cur, nxt; int ui = 0;
    if (!S.next(0, cur)) return;
    f32x4 acc[2][2][4][2];
#pragma unroll
    for (int a = 0; a < 2; ++a)
#pragma unroll
        for (int b = 0; b < 2; ++b)
#pragma unroll
            for (int m = 0; m < 4; ++m)
#pragma unroll
                for (int n = 0; n < 2; ++n) acc[a][b][m][n] = (f32x4){0.f, 0.f, 0.f, 0.f};
    bf16x8 At[4][2], B0[2][2], B1[2][2];
    const char* cA = (const char*)g.A + (size_t)cur.pm * tstep; const char* cB = (const char*)g.Bt + (size_t)cur.pn * tstep;
    S.a_ready(cur);
    if constexpr (SP2) {
        PG8_STAGE(PG8_SB(0, 0), cB, voffB); PG8_STAGE(PG8_SB(0, 1), cB + hstep, voffB); PG8_STAGE(PG8_SA(0, 0), cA, voffA); PG8_STAGE(PG8_SA(0, 1), cA + hstep, voffA);
        if (wr == 1) PG8_BAR;
        PG8_WAIT_V(2); PG8_BAR;
        PG8_STAGE(PG8_SB(1, 0), cB + kstep, voffB); PG8_STAGE(PG8_SA(1, 0), cA + kstep, voffA); PG8_STAGE(PG8_SB(1, 1), cB + hstep + kstep, voffB);
        PG8_WAIT_V(6); PG8_BAR;
    } else {
        PG8_STAGE(PG8_SB(0, 0), cB, voffB); PG8_STAGE(PG8_SA(0, 0), cA, voffA); PG8_STAGE(PG8_SB(0, 1), cB + hstep, voffB); PG8_STAGE(PG8_SA(0, 1), cA + hstep, voffA);
        if (wr == 1) PG8_BAR;
        PG8_WAIT_V(4); PG8_BAR;
        PG8_STAGE(PG8_SB(1, 0), cB + kstep, voffB); PG8_STAGE(PG8_SA(1, 0), cA + kstep, voffA); PG8_STAGE(PG8_SB(1, 1), cB + hstep + kstep, voffB);
        PG8_WAIT_V(6); PG8_BAR;
    }
    for (;;) {
        const bool has_next = S.next(ui + 1, nxt);
        const char* nA = has_next ? (const char*)g.A + (size_t)nxt.pm * tstep : cA; const char* nB = has_next ? (const char*)g.Bt + (size_t)nxt.pn * tstep : cB;
        for (int t = 0; t < nt; t += 2) {
            const bool last = (t == nt - 2);
            const char* a1 = cA + (size_t)(t + 1) * kstep;
            const char* a2 = last ? nA : cA + (size_t)(t + 2) * kstep; const char* b2 = last ? nB : cB + (size_t)(t + 2) * kstep;
            const char* a3 = a2 + kstep; const char* b3 = b2 + kstep;
            if (last && has_next) S.a_ready(nxt);
            if constexpr (SP2) {
            PG8_LDB(B0, 0, 0); PG8_LDB(B1, 0, 1); PG8_SCHED; PG8_LDA(At, 0, 0); PG8_STAGE(PG8_SA(1, 1), a1 + hstep, voffA);
            PG8_WAIT_V(8); PG8_WAIT_L(0); PG8_BAR; PG8_MMA(0, 0, At, B0); PG8_MMA(0, 1, At, B1); PG8_BAR; PG8_SCHED;
            PG8_LDA(At, 0, 1); PG8_STAGE(PG8_SB(0, 0), b2, voffB); PG8_STAGE(PG8_SB(0, 1), b2 + hstep, voffB); PG8_STAGE(PG8_SA(0, 0), a2, voffA);
            PG8_WAIT_V(8); PG8_WAIT_L(0); PG8_BAR; PG8_MMA(1, 0, At, B0); PG8_MMA(1, 1, At, B1); PG8_BAR; PG8_SCHED;
            PG8_LDB(B0, 1, 0); PG8_LDB(B1, 1, 1); PG8_SCHED; PG8_LDA(At, 1, 0); PG8_STAGE(PG8_SA(0, 1), a2 + hstep, voffA);
            PG8_WAIT_V(8); PG8_WAIT_L(0); PG8_BAR; PG8_MMA(0, 0, At, B0); PG8_MMA(0, 1, At, B1); PG8_BAR; PG8_SCHED;
            PG8_LDA(At, 1, 1); PG8_STAGE(PG8_SB(1, 0), b3, voffB); PG8_STAGE(PG8_SB(1, 1), b3 + hstep, voffB); PG8_STAGE(PG8_SA(1, 0), a3, voffA);
            PG8_WAIT_V(8); PG8_WAIT_L(0); PG8_BAR; PG8_MMA(1, 0, At, B0); PG8_MMA(1, 1, At, B1); PG8_BAR; PG8_SCHED;
            } else {
            PG8_LDB(B0, 0, 0); PG8_SCHED; PG8_LDA(At, 0, 0); PG8_STAGE(PG8_SA(1, 1), a1 + hstep, voffA);
            PG8_WAIT_L(8); PG8_BAR; PG8_WAIT_L(0); PG8_MMA(0, 0, At, B0); PG8_BAR; PG8_SCHED;
            PG8_LDB(B1, 0, 1); PG8_STAGE(PG8_SB(0, 0), b2, voffB);
            PG8_BAR; PG8_WAIT_L(0); PG8_MMA(0, 1, At, B1); PG8_BAR;
            PG8_LDA(At, 0, 1); PG8_STAGE(PG8_SA(0, 0), a2, voffA);
            PG8_BAR; PG8_WAIT_L(0); PG8_MMA(1, 0, At, B0); PG8_BAR; PG8_SCHED;
            PG8_STAGE(PG8_SB(0, 1), b2 + hstep, voffB);
            PG8_WAIT_V(6); PG8_BAR; PG8_MMA(1, 1, At, B1); PG8_BAR;
            PG8_LDB(B0, 1, 0); PG8_SCHED; PG8_LDA(At, 1, 0); PG8_STAGE(PG8_SA(0, 1), a2 + hstep, voffA);
            PG8_WAIT_L(8); PG8_BAR; PG8_WAIT_L(0); PG8_MMA(0, 0, At, B0); PG8_BAR; PG8_SCHED;
            PG8_LDB(B1, 1, 1); PG8_STAGE(PG8_SB(1, 0), b3, voffB);
            PG8_BAR; PG8_WAIT_L(0); PG8_MMA(0, 1, At, B1); PG8_BAR;
            PG8_LDA(At, 1, 1); PG8_STAGE(PG8_SA(1, 0), a3, voffA);
            PG8_BAR; PG8_WAIT_L(0); PG8_MMA(1, 0, At, B0); PG8_BAR; PG8_SCHED;
            PG8_STAGE(PG8_SB(1, 1), b3 + hstep, voffB);
            PG8_WAIT_V(6); PG8_BAR; PG8_MMA(1, 1, At, B1); PG8_BAR;
            }
        }
        if constexpr (ALIGN_EPI) { if (wr == 0) PG8_BAR; }
        if constexpr (!Epi::AFTER_DRAIN) { E(acc, cur, wr, wc, fr, fq); S.done(cur); }
        if (!has_next) break;
#pragma unroll
        for (int a = 0; a < 2; ++a)
#pragma unroll
            for (int b = 0; b < 2; ++b)
#pragma unroll
                for (int m = 0; m < 4; ++m)
#pragma unroll
                    for (int n = 0; n < 2; ++n) acc[a][b][m][n] = (f32x4){0.f, 0.f, 0.f, 0.f};
        cur = nxt; cA = nA; cB = nB; ++ui;
        if constexpr (ALIGN_EPI) { if (wr == 1) PG8_BAR; }
    }
    PG8_WAIT_V(0);
    if constexpr (!ALIGN_EPI) { if (wr == 0) PG8_BAR; }
    PG8_BAR;
#undef PG8_SA
#undef PG8_SB
#undef PG8_STAGE
#undef PG8_LDA
#undef PG8_LDB
#undef PG8_MMA
#undef PG8_WAIT_V
#undef PG8_WAIT_L
#undef PG8_BAR
#undef PG8_SCHED
}
}
using pg8::cvt_pk_bf16;

#define LDS_WAIT() asm volatile("s_waitcnt lgkmcnt(0)" ::: "memory")
__device__ __forceinline__ float bf_lo(unsigned w) { return __uint_as_float(w << 16); }
__device__ __forceinline__ float bf_hi(unsigned w) { return __uint_as_float(w & 0xffff0000u); }
__device__ __forceinline__ float wave_sum(float v) {
#pragma unroll
    for (int o = 1; o < 64; o <<= 1) v += __shfl_xor(v, o);
    return v;
}
__device__ __forceinline__ float fast_exp2(float x) { return __builtin_amdgcn_exp2f(x); }
__device__ __forceinline__ float silu_f(float g) { return g / (1.0f + __expf(-g)); }
__device__ __forceinline__ float log_sigmoid_f(float d) { return d >= 0.f ? -log1pf(expf(-d)) : d - log1pf(expf(d)); }

__device__ __forceinline__ void sincos_acc(float ang, float& s, float& c) {
    const double a = (double)ang;
    const double kq = __builtin_rint(a * 0.63661977236758134308);
    double r = __builtin_fma(-kq, 1.57079632679489661923, a);
    r = __builtin_fma(-kq, 6.12323399573676603587e-17, r);
    const double r2 = r * r;
    const double sp = r * (1.0 + r2 * (-1.0 / 6 + r2 * (1.0 / 120 + r2 * (-1.0 / 5040 + r2 * (1.0 / 362880 + r2 * (-1.0 / 39916800))))));
    const double cp = 1.0 + r2 * (-0.5 + r2 * (1.0 / 24 + r2 * (-1.0 / 720 + r2 * (1.0 / 40320 + r2 * (-1.0 / 3628800 + r2 * (1.0 / 479001600))))));
    const int q = ((int)kq) & 3;
    const double ss = (q & 1) ? cp : sp, cc = (q & 1) ? sp : cp;
    s = (float)((q & 2) ? -ss : ss);
    c = (float)(((q + 1) & 2) ? -cc : cc);
}

constexpr int TPB = 272;
constexpr int TS = 128 * TPB;
constexpr int LDS_MISC = 4 * TS;
constexpr int LDS_BYTES = 143360;

typedef short v4i16_t __attribute__((ext_vector_type(4)));
__device__ __forceinline__ bf16x8 frag_row(LAS const unsigned char* tile, int row, int k) { return *(LAS const bf16x8*)(tile + row * TPB + k * 2); }
__device__ __forceinline__ bf16x8 frag_col(LAS const unsigned char* tile, int k0, int n0, int fr, int fq) {
    LAS const unsigned char* a = tile + (k0 + 8 * fq + (fr >> 2)) * TPB + (n0 + 4 * (fr & 3)) * 2;
    const s16x4 lo = __builtin_bit_cast(s16x4, __builtin_amdgcn_ds_read_tr16_b64_v4i16((LAS v4i16_t*)a));
    const s16x4 hi = __builtin_bit_cast(s16x4, __builtin_amdgcn_ds_read_tr16_b64_v4i16((LAS v4i16_t*)(a + 4 * TPB)));
    return (bf16x8){lo[0], lo[1], lo[2], lo[3], hi[0], hi[1], hi[2], hi[3]};
}
#define MFMA16(a, b, c) __builtin_amdgcn_mfma_f32_16x16x32_bf16((a), (b), (c), 0, 0, 0)
__device__ __forceinline__ void stage_tile(LAS unsigned char* dst, const bf16_t* src, size_t ld, int tid) {
    u32x4 v[4];
#pragma unroll
    for (int i = 0; i < 4; ++i) { const int c = tid + 512 * i; v[i] = *(const u32x4*)(src + (size_t)(c >> 4) * ld + (c & 15) * 8); }
#pragma unroll
    for (int i = 0; i < 4; ++i) { const int c = tid + 512 * i; *(LAS u32x4*)(dst + (c >> 4) * TPB + (c & 15) * 16) = v[i]; }
}

struct Params {
    const float *x, *w_in, *w_out, *norm_w, *dec_f, *dec_b, *gn_w, *gn_b, *sink, *fnw;
    float* out; unsigned char* ws;
};

__device__ __forceinline__ void p0_transpose_item(const float* W, const float* rowscale, int K, int N, bf16_t* WT, LAS float* scr, int item, int lane) {
    const int nblk = N / 32, kb = item / nblk, nb = item % nblk, k0 = 64 * kb, n0 = 32 * nb;
#pragma unroll 8
    for (int i = 0; i < 32; ++i) { const int kk = 2 * i + (lane >> 5); float v = W[(size_t)(k0 + kk) * N + n0 + (lane & 31)]; if (rowscale) v *= rowscale[k0 + kk]; scr[kk * 33 + (lane & 31)] = v; }
    LDS_WAIT();
    const int c = lane & 7;
#pragma unroll
    for (int j = 0; j < 4; ++j) { const int n = (lane >> 3) + 8 * j; const LAS float* s = scr + (8 * c) * 33 + n;
        u32x4 o; o.x = cvt_pk_bf16(s[0 * 33], s[1 * 33]); o.y = cvt_pk_bf16(s[2 * 33], s[3 * 33]); o.z = cvt_pk_bf16(s[4 * 33], s[5 * 33]); o.w = cvt_pk_bf16(s[6 * 33], s[7 * 33]);
        *(u32x4*)(WT + (size_t)(n0 + n) * K + k0 + 8 * c) = o; }
    LDS_WAIT();
}

__device__ __forceinline__ void scan_item(int item, const Params& p, LAS unsigned char* lds, int tid) {
    const int lane = tid & 63, wid = __builtin_amdgcn_readfirstlane(tid >> 6), fr = lane & 15, fq = lane >> 4;
    const int dir = item & 1, bh = item >> 1, b = bh >> 3, h = bh & 7;
    const float lg = log_sigmoid_f(dir ? p.dec_b[h] : p.dec_f[h]);
    const float cd = expf(lg * 128.0f);
    const bf16_t* proj = (const bf16_t*)(p.ws + WS_PROJ);
    const bf16_t* kbase = proj + (size_t)b * SEQ * NP + C_RK + h * 128;
    const bf16_t* vbase = proj + (size_t)b * SEQ * NP + C_RV + h * 128;
    bf16_t* sbase = (bf16_t*)(p.ws + WS_STATE) + ((size_t)(dir * 32 + bh) * NCH) * 16384;
    const int ch = tid & 15, rbase = tid >> 4;
    float dec[4];
#pragma unroll
    for (int i = 0; i < 4; ++i) { const int row = rbase + 32 * i; dec[i] = expf(lg * (float)(dir ? row : 127 - row)) * QK_SCALE; }
    f32x4 acc[8];
#pragma unroll
    for (int mt = 0; mt < 8; ++mt) acc[mt] = (f32x4){0.f, 0.f, 0.f, 0.f};
    u32x4 kr[4], vr[4];
    const int n0 = dir ? NCH - 1 : 0, stp = dir ? -1 : 1;
#define SCAN_GLOAD(n) do { const bf16_t* kp = kbase + (size_t)(n) * 128 * NP; const bf16_t* vp = vbase + (size_t)(n) * 128 * NP; \
    _Pragma("unroll") for (int i = 0; i < 4; ++i) { const size_t o = (size_t)(rbase + 32 * i) * NP + ch * 8; kr[i] = *(const u32x4*)(kp + o); vr[i] = *(const u32x4*)(vp + o); } } while (0)
#define SCAN_LWRITE(buf) do { LAS unsigned char* kt = lds + (buf) * TS; LAS unsigned char* vt = lds + (2 + (buf)) * TS; \
    _Pragma("unroll") for (int i = 0; i < 4; ++i) { const int o = (rbase + 32 * i) * TPB + ch * 16; const float d = dec[i]; u32x4 w; \
        w.x = cvt_pk_bf16(bf_lo(kr[i].x) * d, bf_hi(kr[i].x) * d); w.y = cvt_pk_bf16(bf_lo(kr[i].y) * d, bf_hi(kr[i].y) * d); \
        w.z = cvt_pk_bf16(bf_lo(kr[i].z) * d, bf_hi(kr[i].z) * d); w.w = cvt_pk_bf16(bf_lo(kr[i].w) * d, bf_hi(kr[i].w) * d); \
        *(LAS u32x4*)(kt + o) = w; *(LAS u32x4*)(vt + o) = vr[i]; } } while (0)
    __syncthreads();
    SCAN_GLOAD(n0); SCAN_LWRITE(0);
    __syncthreads();
    for (int s = 0; s < NCH; ++s) {
        const int n = n0 + s * stp;
        if (s + 1 < NCH) SCAN_GLOAD(n + stp);
        bf16_t* sp = sbase + (size_t)n * 16384 + (16 * wid + fr) * 128 + 4 * fq;
#pragma unroll
        for (int mt = 0; mt < 8; ++mt) { u32x2 w; w.x = cvt_pk_bf16(acc[mt][0], acc[mt][1]); w.y = cvt_pk_bf16(acc[mt][2], acc[mt][3]); *(u32x2*)(sp + 16 * mt) = w; acc[mt] = acc[mt] * cd; }
        LAS const unsigned char* kt = lds + (s & 1) * TS; LAS const unsigned char* vt = lds + (2 + (s & 1)) * TS;
#pragma unroll
        for (int ks = 0; ks < 4; ++ks) { const bf16x8 kf = frag_col(kt, 32 * ks, 16 * wid, fr, fq);
#pragma unroll
            for (int mt = 0; mt < 8; ++mt) acc[mt] = MFMA16(frag_col(vt, 32 * ks, 16 * mt, fr, fq), kf, acc[mt]); }
        if (s + 1 < NCH) SCAN_LWRITE((s + 1) & 1);
        __syncthreads();
    }
#undef SCAN_GLOAD
#undef SCAN_LWRITE
}

__device__ __forceinline__ void attn_item(int item, const Params& p, LAS unsigned char* lds, int tid) {
    const int lane = tid & 63, wid = __builtin_amdgcn_readfirstlane(tid >> 6), fr = lane & 15, fq = lane >> 4;
    const int g = item & 3, n = (item >> 2) & 31, kvh = (item >> 7) & 1, b = item >> 8, h = kvh * 4 + g;
    const bf16_t* proj = (const bf16_t*)(p.ws + WS_PROJ);
    const size_t tok0 = (size_t)b * SEQ + (size_t)n * 128;
    const bf16_t* qsrc = proj + tok0 * NP + C_AQ + h * 128;
    const bf16_t* ksrc = proj + tok0 * NP + C_AK + kvh * 128;
    const bf16_t* vsrc = proj + tok0 * NP + C_AV + kvh * 128;
    LAS unsigned char* R0 = lds; LAS unsigned char* R1 = lds + TS; LAS unsigned char* R2 = lds + 2 * TS; LAS unsigned char* R3 = lds + 3 * TS;
    const bool hasp = n > 0, hasn = n < NCH - 1;
    __syncthreads();
    stage_tile(R0, qsrc, NP, tid);
    if (hasp) stage_tile(R1, ksrc - (size_t)128 * NP, NP, tid);
    stage_tile(R2, ksrc, NP, tid);
    if (hasn) stage_tile(R3, ksrc + (size_t)128 * NP, NP, tid);
    __syncthreads();
    const int i0 = 16 * wid, iq = i0 + fr;
    bf16x8 qf[4];
#pragma unroll
    for (int ks = 0; ks < 4; ++ks) qf[ks] = frag_row(R0, iq, 32 * ks + 8 * fq);
    f32x4 S[3][8];
    const float NEG = -1e30f;
#pragma unroll
    for (int kb = 0; kb < 3; ++kb) {
        const bool valid = kb == 0 ? hasp : (kb == 2 ? hasn : true);
        LAS const unsigned char* kt = lds + (1 + kb) * TS;
        if (valid) {
#pragma unroll
            for (int jt = 0; jt < 8; ++jt) { f32x4 a = (f32x4){0.f, 0.f, 0.f, 0.f};
#pragma unroll
                for (int ks = 0; ks < 4; ++ks) a = MFMA16(frag_row(kt, 16 * jt + fr, 32 * ks + 8 * fq), qf[ks], a);
#pragma unroll
                for (int r = 0; r < 4; ++r) { const int j = 16 * jt + 4 * fq + r; float s = a[r] * QK_SCALE;
                    if (kb == 0 && j < iq) s = NEG;
                    if (kb == 2 && j > iq) s = NEG;
                    a[r] = s; }
                S[kb][jt] = a; }
        } else {
#pragma unroll
            for (int jt = 0; jt < 8; ++jt) S[kb][jt] = (f32x4){NEG, NEG, NEG, NEG};
        }
    }
    const float sk = p.sink[h];
    float mx = sk;
#pragma unroll
    for (int kb = 0; kb < 3; ++kb)
#pragma unroll
        for (int jt = 0; jt < 8; ++jt) mx = fmaxf(mx, fmaxf(fmaxf(S[kb][jt][0], S[kb][jt][1]), fmaxf(S[kb][jt][2], S[kb][jt][3])));
    mx = fmaxf(mx, __shfl_xor(mx, 16)); mx = fmaxf(mx, __shfl_xor(mx, 32));
    float l = 0.f;
#pragma unroll
    for (int kb = 0; kb < 3; ++kb)
#pragma unroll
        for (int jt = 0; jt < 8; ++jt) { f32x4 e;
#pragma unroll
            for (int r = 0; r < 4; ++r) { e[r] = fast_exp2((S[kb][jt][r] - mx) * LOG2E); l += e[r]; }
            S[kb][jt] = e; }
    l += __shfl_xor(l, 16); l += __shfl_xor(l, 32);
    l += fast_exp2((sk - mx) * LOG2E);
    const float inv = 1.0f / l;
    __syncthreads();
    if (hasp) stage_tile(R1, vsrc - (size_t)128 * NP, NP, tid);
    stage_tile(R2, vsrc, NP, tid);
    if (hasn) stage_tile(R3, vsrc + (size_t)128 * NP, NP, tid);
    __syncthreads();
    f32x4 O[8];
#pragma unroll
    for (int mt = 0; mt < 8; ++mt) O[mt] = (f32x4){0.f, 0.f, 0.f, 0.f};
#pragma unroll
    for (int kb = 0; kb < 3; ++kb) {
        const bool valid = kb == 0 ? hasp : (kb == 2 ? hasn : true);
        if (valid) {
            LAS const unsigned char* vt = lds + (1 + kb) * TS;
#pragma unroll
            for (int jt = 0; jt < 8; ++jt) { u32x2 w; w.x = cvt_pk_bf16(S[kb][jt][0], S[kb][jt][1]); w.y = cvt_pk_bf16(S[kb][jt][2], S[kb][jt][3]);
                *(LAS u32x2*)(R0 + iq * TPB + (16 * jt + 4 * fq) * 2) = w; }
            asm volatile("s_waitcnt lgkmcnt(0)" ::: "memory");
#pragma unroll
            for (int ks = 0; ks < 4; ++ks) { const bf16x8 pf = frag_row(R0, iq, 32 * ks + 8 * fq);
#pragma unroll
                for (int mt = 0; mt < 8; ++mt) O[mt] = MFMA16(frag_col(vt, 32 * ks, 16 * mt, fr, fq), pf, O[mt]); }
            asm volatile("s_waitcnt lgkmcnt(0)" ::: "memory");
        }
    }
    const size_t tok = tok0 + iq;
    const bf16_t* gp = proj + tok * NP + C_AG + h * 128 + 4 * fq;
    bf16_t* yp = (bf16_t*)(p.ws + WS_Y) + tok * DM + 1024 + h * 128 + 4 * fq;
#pragma unroll
    for (int mt = 0; mt < 8; ++mt) { const u32x2 gw = *(const u32x2*)(gp + 16 * mt);
        const float o0 = O[mt][0] * inv * silu_f(bf_lo(gw.x)), o1 = O[mt][1] * inv * silu_f(bf_hi(gw.x)), o2 = O[mt][2] * inv * silu_f(bf_lo(gw.y)), o3 = O[mt][3] * inv * silu_f(bf_hi(gw.y));
        u32x2 w; w.x = cvt_pk_bf16(o0, o1); w.y = cvt_pk_bf16(o2, o3); *(u32x2*)(yp + 16 * mt) = w; }
}

__device__ __forceinline__ void ret_item(int item, const Params& p, LAS unsigned char* lds, int tid) {
    const int lane = tid & 63, wid = __builtin_amdgcn_readfirstlane(tid >> 6), fr = lane & 15, fq = lane >> 4;
    const int n = item & 31, bh = item >> 5, b = bh >> 3, h = bh & 7;
    const bf16_t* proj = (const bf16_t*)(p.ws + WS_PROJ);
    const size_t tok0 = (size_t)b * SEQ + (size_t)n * 128;
    const bf16_t* qsrc = proj + tok0 * NP + C_RQ + h * 128;
    const bf16_t* ksrc = proj + tok0 * NP + C_RK + h * 128;
    const bf16_t* vsrc = proj + tok0 * NP + C_RV + h * 128;
    const bf16_t* sf = (const bf16_t*)(p.ws + WS_STATE) + ((size_t)(0 * 32 + bh) * NCH + n) * 16384;
    const bf16_t* sb = (const bf16_t*)(p.ws + WS_STATE) + ((size_t)(1 * 32 + bh) * NCH + n) * 16384;
    LAS unsigned char* R0 = lds; LAS unsigned char* R1 = lds + TS; LAS unsigned char* R2 = lds + 2 * TS; LAS unsigned char* R3 = lds + 3 * TS;
    const float lgf2 = log_sigmoid_f(p.dec_f[h]) * LOG2E, lgb2 = log_sigmoid_f(p.dec_b[h]) * LOG2E;
    __syncthreads();
    stage_tile(R0, qsrc, NP, tid); stage_tile(R1, ksrc, NP, tid); stage_tile(R2, vsrc, NP, tid); stage_tile(R3, sf, 128, tid);
    __syncthreads();
    const int i0 = 16 * wid, iq = i0 + fr;
    bf16x8 qf[4];
#pragma unroll
    for (int ks = 0; ks < 4; ++ks) qf[ks] = frag_row(R0, iq, 32 * ks + 8 * fq);
#pragma unroll
    for (int jt = 0; jt < 8; ++jt) { f32x4 a = (f32x4){0.f, 0.f, 0.f, 0.f};
#pragma unroll
        for (int ks = 0; ks < 4; ++ks) a = MFMA16(frag_row(R1, 16 * jt + fr, 32 * ks + 8 * fq), qf[ks], a);
#pragma unroll
        for (int r = 0; r < 4; ++r) { const int j = 16 * jt + 4 * fq + r; const int d = iq - j;
            const float e = d >= 0 ? lgf2 * (float)d : lgb2 * (float)(-d);
            a[r] = a[r] * (QK_SCALE * fast_exp2(e)); }
        u32x2 w; w.x = cvt_pk_bf16(a[0], a[1]); w.y = cvt_pk_bf16(a[2], a[3]);
        *(LAS u32x2*)(R0 + iq * TPB + (16 * jt + 4 * fq) * 2) = w; }
    asm volatile("s_waitcnt lgkmcnt(0)" ::: "memory");
    f32x4 O[8], Of[8], Ob[8];
#pragma unroll
    for (int mt = 0; mt < 8; ++mt) { O[mt] = (f32x4){0.f, 0.f, 0.f, 0.f}; Of[mt] = O[mt]; Ob[mt] = O[mt]; }
#pragma unroll
    for (int ks = 0; ks < 4; ++ks) { const bf16x8 pf = frag_row(R0, iq, 32 * ks + 8 * fq);
#pragma unroll
        for (int mt = 0; mt < 8; ++mt) { O[mt] = MFMA16(frag_col(R2, 32 * ks, 16 * mt, fr, fq), pf, O[mt]);
            Of[mt] = MFMA16(frag_col(R3, 32 * ks, 16 * mt, fr, fq), qf[ks], Of[mt]); } }
    __syncthreads();
    stage_tile(R3, sb, 128, tid);
    __syncthreads();
#pragma unroll
    for (int ks = 0; ks < 4; ++ks)
#pragma unroll
        for (int mt = 0; mt < 8; ++mt) Ob[mt] = MFMA16(frag_col(R3, 32 * ks, 16 * mt, fr, fq), qf[ks], Ob[mt]);
    const float rf = fast_exp2(lgf2 * (float)(iq + 1)), rb = fast_exp2(lgb2 * (float)(128 - iq));
    float sum = 0.f;
#pragma unroll
    for (int mt = 0; mt < 8; ++mt) { O[mt] = O[mt] + Of[mt] * rf + Ob[mt] * rb; sum += (O[mt][0] + O[mt][1]) + (O[mt][2] + O[mt][3]); }
    sum += __shfl_xor(sum, 16); sum += __shfl_xor(sum, 32);
    const float mu = sum * (1.0f / 128.0f);
    float var = 0.f;
#pragma unroll
    for (int mt = 0; mt < 8; ++mt) { O[mt] = O[mt] - mu; var += (O[mt][0] * O[mt][0] + O[mt][1] * O[mt][1]) + (O[mt][2] * O[mt][2] + O[mt][3] * O[mt][3]); }
    var += __shfl_xor(var, 16); var += __shfl_xor(var, 32);
    const float rs = 1.0f / sqrtf(var * (1.0f / 128.0f) + 1e-5f);
    const size_t tok = tok0 + iq;
    const bf16_t* gp = proj + tok * NP + C_RG + h * 128 + 4 * fq;
    const float* gw = p.gn_w + h * 128 + 4 * fq; const float* gb = p.gn_b + h * 128 + 4 * fq;
    bf16_t* yp = (bf16_t*)(p.ws + WS_Y) + tok * DM + h * 128 + 4 * fq;
#pragma unroll
    for (int mt = 0; mt < 8; ++mt) { const u32x2 gt = *(const u32x2*)(gp + 16 * mt); const f32x4 w4 = *(const f32x4*)(gw + 16 * mt), b4 = *(const f32x4*)(gb + 16 * mt);
        const float o0 = (O[mt][0] * rs * w4[0] + b4[0]) * silu_f(bf_lo(gt.x)), o1 = (O[mt][1] * rs * w4[1] + b4[1]) * silu_f(bf_hi(gt.x));
        const float o2 = (O[mt][2] * rs * w4[2] + b4[2]) * silu_f(bf_lo(gt.y)), o3 = (O[mt][3] * rs * w4[3] + b4[3]) * silu_f(bf_hi(gt.y));
        u32x2 w; w.x = cvt_pk_bf16(o0, o1); w.y = cvt_pk_bf16(o2, o3); *(u32x2*)(yp + 16 * mt) = w; }
}

__global__ void __launch_bounds__(512, 2) fwd_kernel(Params p) {
    extern __shared__ __attribute__((aligned(16))) unsigned char lds_raw[];
    LAS unsigned char* lds = (LAS unsigned char*)lds_raw;
    cg::grid_group grid = cg::this_grid();
    const int tid = threadIdx.x, lane = tid & 63, wave = __builtin_amdgcn_readfirstlane(tid >> 6);
    const int G = gridDim.x, bid = blockIdx.x;
    const int gw = bid * 8 + wave, NGW = G * 8;
    const size_t gtid = (size_t)bid * 512 + tid, NT = (size_t)G * 512;
    unsigned char* ws = p.ws;
    unsigned* ctl = (unsigned*)(ws + WS_CTL);
    float* cosr = (float*)(ws + WS_COSR); float* sinr = (float*)(ws + WS_SINR); float* cosa = (float*)(ws + WS_COSA); float* sina = (float*)(ws + WS_SINA);
    float* rstd = (float*)(ws + WS_RSTD);
    bf16_t* win_t = (bf16_t*)(ws + WS_WIN); bf16_t* wout_t = (bf16_t*)(ws + WS_WOUT); bf16_t* xb = (bf16_t*)(ws + WS_XB);
    bf16_t* proj = (bf16_t*)(ws + WS_PROJ); bf16_t* yb = (bf16_t*)(ws + WS_Y);

    {
        if (bid == 0 && tid == 0) ctl[0] = 0u;
        LAS float* scr = (LAS float*)(lds + wave * 16384);
        constexpr int I_IN = (DM / 64) * (NP / 32), I_OUT = (DM / 64) * (DM / 32);
        for (int it = gw; it < I_IN + I_OUT; it += NGW) {
            if (it < I_IN) p0_transpose_item(p.w_in, p.norm_w, DM, NP, win_t, scr, it, lane);
            else p0_transpose_item(p.w_out, nullptr, DM, DM, wout_t, scr, it - I_IN, lane);
        }
        for (int m = gw; m < MTOK; m += NGW) {
            const f32x4* xr = (const f32x4*)(p.x + (size_t)m * DM) + lane;
            f32x4 v[8]; float s = 0.f;
#pragma unroll
            for (int j = 0; j < 8; ++j) { v[j] = xr[64 * j]; s += (v[j][0] * v[j][0] + v[j][1] * v[j][1]) + (v[j][2] * v[j][2] + v[j][3] * v[j][3]); }
            s = wave_sum(s);
            if (lane == 0) rstd[m] = 1.0f / sqrtf(s * (1.0f / DM) + 1e-6f);
            u32x2* o = (u32x2*)(xb + (size_t)m * DM) + lane;
#pragma unroll
            for (int j = 0; j < 8; ++j) { u32x2 w; w.x = cvt_pk_bf16(v[j][0], v[j][1]); w.y = cvt_pk_bf16(v[j][2], v[j][3]); o[64 * j] = w; }
        }
        for (size_t idx = gtid; idx < (size_t)SEQ * 64; idx += NT) { const int pos = (int)(idx >> 6), i = (int)(idx & 63);
            const float invf = powf(10000.0f, -(float)i / 64.0f); float s, c; sincos_acc((float)pos * invf, s, c); cosr[idx] = c; sinr[idx] = s; }
        for (size_t idx = gtid; idx < (size_t)SEQ * 16; idx += NT) { const int pos = (int)(idx >> 4), i = (int)(idx & 15);
            const float invf = powf(500000.0f, -(float)i / 16.0f); float s, c; sincos_acc((float)pos * invf, s, c); cosa[idx] = c; sina[idx] = s; }
    }
    grid.sync();

    {
        pg8::Gemm g{xb, win_t, MTOK, NP, DM}; pg8::StaticOrder S; S.init(MTOK, NP, G, bid);
        pg8::EpiProj E{proj, NP, rstd};
        pg8::gemm_phase<pg8::EpiProj, pg8::StaticOrder, true, true>(lds, g, S, E);
    }
    grid.sync();

    {
        for (size_t idx = gtid; idx < (size_t)MTOK * 128; idx += NT) {
            const int t = (int)(idx >> 7), u = (int)(idx & 127), hd = u >> 3, gg = u & 7, pos = t & (SEQ - 1);
            bf16_t* p1 = proj + (size_t)t * NP + hd * 128 + 8 * gg; bf16_t* p2 = p1 + 64;
            const u32x4 a = *(const u32x4*)p1, bq = *(const u32x4*)p2;
            const float* cp = cosr + pos * 64 + 8 * gg; const float* sp = sinr + pos * 64 + 8 * gg;
            const f32x4 c0 = *(const f32x4*)cp, c1 = *(const f32x4*)(cp + 4), s0 = *(const f32x4*)sp, s1 = *(const f32x4*)(sp + 4);
            u32x4 o1, o2;
#define ROT2(W, CA, CB, SA, SB) { const float x1l = bf_lo(a.W), x1h = bf_hi(a.W), x2l = bf_lo(bq.W), x2h = bf_hi(bq.W); \
            o1.W = cvt_pk_bf16(x1l * (CA) - x2l * (SA), x1h * (CB) - x2h * (SB)); o2.W = cvt_pk_bf16(x2l * (CA) + x1l * (SA), x2h * (CB) + x1h * (SB)); }
            ROT2(x, c0[0], c0[1], s0[0], s0[1]) ROT2(y, c0[2], c0[3], s0[2], s0[3]) ROT2(z, c1[0], c1[1], s1[0], s1[1]) ROT2(w, c1[2], c1[3], s1[2], s1[3])
            *(u32x4*)p1 = o1; *(u32x4*)p2 = o2;
        }
        for (size_t idx = gtid; idx < (size_t)MTOK * 20; idx += NT) {
            const int t = (int)(idx / 20), u = (int)(idx % 20), pos = t & (SEQ - 1);
            const int hh = u >> 1, gg = u & 1;
            const int colb = hh < 8 ? C_AQ + hh * 128 : C_AK + (hh - 8) * 128;
            bf16_t* p1 = proj + (size_t)t * NP + colb + 8 * gg; bf16_t* p2 = p1 + 16;
            const u32x4 a = *(const u32x4*)p1, bq = *(const u32x4*)p2;
            const float* cp = cosa + pos * 16 + 8 * gg; const float* sp = sina + pos * 16 + 8 * gg;
            const f32x4 c0 = *(const f32x4*)cp, c1 = *(const f32x4*)(cp + 4), s0 = *(const f32x4*)sp, s1 = *(const f32x4*)(sp + 4);
            u32x4 o1, o2;
            ROT2(x, c0[0], c0[1], s0[0], s0[1]) ROT2(y, c0[2], c0[3], s0[2], s0[3]) ROT2(z, c1[0], c1[1], s1[0], s1[1]) ROT2(w, c1[2], c1[3], s1[2], s1[3])
#undef ROT2
            *(u32x4*)p1 = o1; *(u32x4*)p2 = o2;
        }
    }
    grid.sync();

    {
        LAS volatile int* slot = (LAS volatile int*)(lds + LDS_MISC);
        for (;;) {
            __syncthreads();
            if (tid == 0) *slot = (int)atomicAdd(ctl, 1u);
            __syncthreads();
            const int item = *slot;
            if (item >= 64 + 1024) break;
            if (item < 64) scan_item(item, p, lds, tid);
            else attn_item(item - 64, p, lds, tid);
        }
    }
    grid.sync();

    for (int item = bid; item < 1024; item += G) ret_item(item, p, lds, tid);
    grid.sync();

    {
        pg8::Gemm g{yb, wout_t, MTOK, DM, DM}; pg8::StaticOrder S; S.init(MTOK, DM, G, bid);
        pg8::EpiRes E{p.x, p.out, DM};
        pg8::gemm_phase<pg8::EpiRes, pg8::StaticOrder, true, true>(lds, g, S, E);
    }
    grid.sync();

    for (int m = gw; m < MTOK; m += NGW) {
        f32x4* xr = (f32x4*)(p.out + (size_t)m * DM) + lane;
        const f32x4* wr4 = (const f32x4*)p.fnw + lane;
        f32x4 v[8]; float s = 0.f;
#pragma unroll
        for (int j = 0; j < 8; ++j) { v[j] = xr[64 * j]; s += (v[j][0] * v[j][0] + v[j][1] * v[j][1]) + (v[j][2] * v[j][2] + v[j][3] * v[j][3]); }
        s = wave_sum(s);
        const float rs = 1.0f / sqrtf(s * (1.0f / DM) + 1e-6f);
#pragma unroll
        for (int j = 0; j < 8; ++j) xr[64 * j] = v[j] * rs * wr4[64 * j];
    }
}

extern "C" void kernel_launch(void* const* d_in, const int* in_sizes, int n_in, void* d_out, int out_size, void* d_ws, size_t ws_size, hipStream_t stream) {
    static int grid = 0;
    if (grid == 0) {
        if (n_in != 10 || in_sizes[0] != MTOK * DM || out_size != MTOK * DM || ws_size < WS_END) {
            fprintf(stderr, "kernel_launch: unexpected shapes (n_in %d, in0 %d, out %d, ws %zu)\n", n_in, n_in > 0 ? in_sizes[0] : -1, out_size, ws_size); grid = -1; return; }
        int dev = 0, cus = 0, per_cu = 0;
        hipGetDevice(&dev);
        hipDeviceGetAttribute(&cus, hipDeviceAttributeMultiprocessorCount, dev);
        hipFuncSetAttribute((const void*)fwd_kernel, hipFuncAttributeMaxDynamicSharedMemorySize, LDS_BYTES);
        hipOccupancyMaxActiveBlocksPerMultiprocessor(&per_cu, (const void*)fwd_kernel, 512, LDS_BYTES);
        if (per_cu < 1) { fprintf(stderr, "kernel_launch: occupancy query says %d blocks per CU\n", per_cu); per_cu = 1; }
        (void)hipGetLastError();
        grid = cus * per_cu;
    }
    if (grid < 0) return;
    Params p{};
    p.x = (const float*)d_in[0]; p.w_in = (const float*)d_in[1]; p.w_out = (const float*)d_in[2]; p.norm_w = (const float*)d_in[3];
    p.dec_f = (const float*)d_in[4]; p.dec_b = (const float*)d_in[5]; p.gn_w = (const float*)d_in[6]; p.gn_b = (const float*)d_in[7];
    p.sink = (const float*)d_in[8]; p.fnw = (const float*)d_in[9];
    p.out = (float*)d_out; p.ws = (unsigned char*)d_ws;
    void* args[] = {&p};
    hipError_t e = hipLaunchCooperativeKernel((const void*)fwd_kernel, dim3(grid), dim3(512), args, LDS_BYTES, stream);
    if (e != hipSuccess) fprintf(stderr, "kernel_launch: cooperative launch failed: %s (grid %d)\n", hipGetErrorString(e), grid);
}
```

```cpp
#include <hip/hip_runtime.h>
#include <hip/hip_cooperative_groups.h>
#include <cstdio>
#include <cstdint>
namespace cg = cooperative_groups;
#ifndef PROBE_DUP
#define PROBE_DUP -1
#endif

#define LAS __attribute__((address_space(3)))
typedef unsigned short bf16_t;
typedef short bf16x8 __attribute__((ext_vector_type(8)));
typedef short s16x4 __attribute__((ext_vector_type(4)));
typedef float f32x4 __attribute__((ext_vector_type(4)));
typedef unsigned u32x4 __attribute__((ext_vector_type(4)));
typedef unsigned u32x2 __attribute__((ext_vector_type(2)));

constexpr int NB_ = 4, SEQ = 4096, DM = 2048, MTOK = NB_ * SEQ;
constexpr int NP = 6656;
constexpr int C_RQ = 0, C_RK = 1024, C_RV = 2048, C_RG = 3072, C_AQ = 4096, C_AK = 5120, C_AV = 5376, C_AG = 5632;
constexpr int NCH = 32;
constexpr float QK_SCALE = 0.08838834764831845f;
constexpr float LOG2E = 1.4426950408889634f;

constexpr size_t MiB = 1u << 20;
constexpr size_t WS_CTL = 0;
constexpr size_t WS_COSR = 1 * MiB, WS_SINR = 2 * MiB, WS_COSA = 3 * MiB, WS_SINA = 3 * MiB + 512 * 1024;
constexpr size_t WS_RSTD = 4 * MiB;
constexpr size_t WS_WIN = 8 * MiB;
constexpr size_t WS_WOUT = 34 * MiB;
constexpr size_t WS_XB = 48 * MiB;
constexpr size_t WS_PROJ = 112 * MiB;
constexpr size_t WS_STATE = 320 * MiB;
constexpr size_t WS_Y = 384 * MiB;
constexpr size_t WS_END = 448 * MiB;

namespace pg8 {
constexpr int BM = 256, BK = 64, HALF = 128, HTB = HALF * BK * 2, STAGE_BYTES = 8 * HTB, NXCD = 8, WGM = 8;
__host__ __device__ __forceinline__ int lds_byte(int r, int c) { const int st = (r >> 4) * 2 + (c >> 5), rr = r & 15, cc = c & 31, ob = rr * 64 + cc * 2; return st * 1024 + (ob ^ (((ob >> 9) & 1) << 5)); }
__host__ __device__ __forceinline__ void stage_rc(int b, int& R, int& C) { const int st = b / 1024, sb = b % 1024, swz = sb ^ (((sb >> 9) & 1) << 5); R = (st >> 1) * 16 + swz / 64; C = (st & 1) * 32 + (swz % 64) / 2; }
__host__ __device__ __forceinline__ int perm32(int rho) { const int n = rho >> 4, i = rho & 15; return 8 * (i >> 2) + 4 * n + (i & 3); }
struct Unit { int pm, pn; };
struct Gemm { const bf16_t* A; const bf16_t* Bt; int M, N, K; };
struct StaticOrder {
    int nM, nN, nwg, G, c;
    __host__ __device__ void init(int M, int N, int G_, int c_) { nM = M / BM; nN = N / BM; nwg = nM * nN; G = G_; c = c_; }
    __host__ __device__ bool next(int i, Unit& u) const {
        const long L = (long)i * G + c; if (L >= nwg) return false;
        int wgid = (int)L; { const int q = nwg / NXCD, r = nwg % NXCD, xcd = wgid % NXCD, off = wgid / NXCD; wgid = (xcd < r ? xcd * (q + 1) : r * (q + 1) + (xcd - r) * q) + off; }
        const int nig = WGM * nN, gid = wgid / nig, fm = gid * WGM, gsz = (nM - fm) < WGM ? (nM - fm) : WGM;
        u.pm = fm + ((wgid % nig) % gsz); u.pn = (wgid % nig) / gsz; return true;
    }
    __device__ __forceinline__ void a_ready(const Unit&) const {}
    __device__ __forceinline__ void done(const Unit&) const {}
};
__device__ __forceinline__ unsigned cvt_pk_bf16(float lo, float hi) { unsigned r; asm volatile("v_cvt_pk_bf16_f32 %0, %1, %2" : "=v"(r) : "v"(lo), "v"(hi)); return r; }

struct EpiProj {
    static constexpr bool PERM = true, AFTER_DRAIN = false;
    bf16_t* O; int ldc; const float* rstd;
    __device__ __forceinline__ void operator()(const f32x4 (&acc)[2][2][4][2], const Unit& u, int wr, int wc, int fr, int fq) const {
        const int row0 = u.pm * BM + wr * 64 + fr; const int col0 = u.pn * BM + wc * 32 + 8 * fq;
#pragma unroll
        for (int ai = 0; ai < 2; ++ai)
#pragma unroll
            for (int m = 0; m < 4; ++m) { const int row = row0 + ai * HALF + m * 16; const float s = rstd[row]; bf16_t* rowp = O + (size_t)row * ldc + col0;
#pragma unroll
                for (int bj = 0; bj < 2; ++bj) { const f32x4 v0 = acc[ai][bj][m][0] * s, v1 = acc[ai][bj][m][1] * s;
                    u32x4 w; w.x = cvt_pk_bf16(v0[0], v0[1]); w.y = cvt_pk_bf16(v0[2], v0[3]); w.z = cvt_pk_bf16(v1[0], v1[1]); w.w = cvt_pk_bf16(v1[2], v1[3]);
                    *(u32x4*)(rowp + bj * HALF) = w; } }
    }
};
struct EpiRes {
    static constexpr bool PERM = false, AFTER_DRAIN = false;
    const float* base; float* out; int ldc;
    __device__ __forceinline__ void operator()(const f32x4 (&acc)[2][2][4][2], const Unit& u, int wr, int wc, int fr, int fq) const {
        const int col0 = u.pn * BM + wc * 32 + 4 * fq;
#pragma unroll
        for (int ai = 0; ai < 2; ++ai)
#pragma unroll
            for (int m = 0; m < 4; ++m) { const size_t off = (size_t)(u.pm * BM + ai * HALF + wr * 64 + m * 16 + fr) * ldc + col0;
#pragma unroll
                for (int bj = 0; bj < 2; ++bj)
#pragma unroll
                    for (int n = 0; n < 2; ++n) { const f32x4 bs = *(const f32x4*)(base + off + bj * HALF + n * 16); *(f32x4*)(out + off + bj * HALF + n * 16) = bs + acc[ai][bj][m][n]; } }
    }
};

template <class Epi, class Sched, bool ALIGN_EPI = false, bool SP2 = false>
__device__ __forceinline__ void gemm_phase(LAS unsigned char* lds, const Gemm g, const Sched& S, const Epi& E) {
    int tid = threadIdx.x; asm volatile("" : "+v"(tid));
    const int wid = __builtin_amdgcn_readfirstlane(tid >> 6), lane = tid & 63, wr = wid >> 2, wc = wid & 3, fr = lane & 15, fq = lane >> 4;
    const int K = g.K, nt = K / BK;
    unsigned voffA[2], voffB[2];
#pragma unroll
    for (int i = 0; i < 2; ++i) { int R, C; stage_rc(tid * 16 + i * 8192, R, C); const int Rb = Epi::PERM ? ((R & ~31) + perm32(R & 31)) : R;
        voffA[i] = (unsigned)(R * K + C) * 2u; voffB[i] = (unsigned)(Rb * K + C) * 2u; }
    const size_t kstep = (size_t)(BK * 2);
    const size_t hstep = (size_t)HALF * K * 2;
    const size_t tstep = 2 * hstep;
    const unsigned ldsw = (unsigned)wid * 1024u;
    const int aoff = lds_byte(wr * 64 + fr, fq * 8), boff = lds_byte(wc * 32 + fr, fq * 8);
#define PG8_SA(b, h) (((b) * 2 + (h)) * HTB)
#define PG8_SB(b, h) ((4 + (b) * 2 + (h)) * HTB)
#define PG8_STAGE(bufoff, gbase, voff) do { _Pragma("unroll") for (int _i = 0; _i < 2; ++_i) \
        __builtin_amdgcn_global_load_lds((const unsigned*)((const char*)(gbase) + (voff)[_i]), (LAS unsigned*)(lds + (bufoff) + ldsw + _i * 8192), 16, 0, 0); } while (0)
#define PG8_LDA(dst, b, h) do { _Pragma("unroll") for (int m = 0; m < 4; ++m) _Pragma("unroll") for (int k = 0; k < 2; ++k) dst[m][k] = *(const LAS bf16x8*)(lds + PG8_SA(b, h) + aoff + m * 2048 + k * 1024); } while (0)
#define PG8_LDB(dst, b, h) do { _Pragma("unroll") for (int n = 0; n < 2; ++n) _Pragma("unroll") for (int k = 0; k < 2; ++k) dst[n][k] = *(const LAS bf16x8*)(lds + PG8_SB(b, h) + boff + n * 2048 + k * 1024); } while (0)
#define PG8_MMA(ai, bj, At, Bt) do { __builtin_amdgcn_s_setprio(1); _Pragma("unroll") for (int m = 0; m < 4; ++m) _Pragma("unroll") for (int n = 0; n < 2; ++n) _Pragma("unroll") for (int k = 0; k < 2; ++k) \
        acc[ai][bj][m][n] = __builtin_amdgcn_mfma_f32_16x16x32_bf16(Bt[n][k], At[m][k], acc[ai][bj][m][n], 0, 0, 0); __builtin_amdgcn_s_setprio(0); } while (0)
#define PG8_WAIT_V(n) asm volatile("s_waitcnt vmcnt(" #n ")" ::: "memory")
#define PG8_WAIT_L(n) asm volatile("s_waitcnt lgkmcnt(" #n ")" ::: "memory")
#define PG8_BAR __builtin_amdgcn_s_barrier()
#define PG8_SCHED __builtin_amdgcn_sched_barrier(0)
    Unit cur, nxt; int ui = 0;
    if (!S.next(0, cur)) return;
    f32x4 acc[2][2][4][2];
#pragma unroll
    for (int a = 0; a < 2; ++a)
#pragma unroll
        for (int b = 0; b < 2; ++b)
#pragma unroll
            for (int m = 0; m < 4; ++m)
#pragma unroll
                for (int n = 0; n < 2; ++n) acc[a][b][m][n] = (f32x4){0.f, 0.f, 0.f, 0.f};
    bf16x8 At[4][2], B0[2][2], B1[2][2];
    const char* cA = (const char*)g.A + (size_t)cur.pm * tstep; const char* cB = (const char*)g.Bt + (size_t)cur.pn * tstep;
    S.a_ready(cur);
    if constexpr (SP2) {
        PG8_STAGE(PG8_SB(0, 0), cB, voffB); PG8_STAGE(PG8_SB(0, 1), cB + hstep, voffB); PG8_STAGE(PG8_SA(0, 0), cA, voffA); PG8_STAGE(PG8_SA(0, 1), cA + hstep, voffA);
        if (wr == 1) PG8_BAR;
        PG8_WAIT_V(2); PG8_BAR;
        PG8_STAGE(PG8_SB(1, 0), cB + kstep, voffB); PG8_STAGE(PG8_SA(1, 0), cA + kstep, voffA); PG8_STAGE(PG8_SB(1, 1), cB + hstep + kstep, voffB);
        PG8_WAIT_V(6); PG8_BAR;
    } else {
        PG8_STAGE(PG8_SB(0, 0), cB, voffB); PG8_STAGE(PG8_SA(0, 0), cA, voffA); PG8_STAGE(PG8_SB(0, 1), cB + hstep, voffB); PG8_STAGE(PG8_SA(0, 1), cA + hstep, voffA);
        if (wr == 1) PG8_BAR;
        PG8_WAIT_V(4); PG8_BAR;
        PG8_STAGE(PG8_SB(1, 0), cB + kstep, voffB); PG8_STAGE(PG8_SA(1, 0), cA + kstep, voffA); PG8_STAGE(PG8_SB(1, 1), cB + hstep + kstep, voffB);
        PG8_WAIT_V(6); PG8_BAR;
    }
    for (;;) {
        const bool has_next = S.next(ui + 1, nxt);
        const char* nA = has_next ? (const char*)g.A + (size_t)nxt.pm * tstep : cA; const char* nB = has_next ? (const char*)g.Bt + (size_t)nxt.pn * tstep : cB;
        for (int t = 0; t < nt; t += 2) {
            const bool last = (t == nt - 2);
            const char* a1 = cA + (size_t)(t + 1) * kstep;
            const char* a2 = last ? nA : cA + (size_t)(t + 2) * kstep; const char* b2 = last ? nB : cB + (size_t)(t + 2) * kstep;
            const char* a3 = a2 + kstep; const char* b3 = b2 + kstep;
            if (last && has_next) S.a_ready(nxt);
            if constexpr (SP2) {
            PG8_LDB(B0, 0, 0); PG8_LDB(B1, 0, 1); PG8_SCHED; PG8_LDA(At, 0, 0); PG8_STAGE(PG8_SA(1, 1), a1 + hstep, voffA);
            PG8_WAIT_V(8); PG8_WAIT_L(0); PG8_BAR; PG8_MMA(0, 0, At, B0); PG8_MMA(0, 1, At, B1); PG8_BAR; PG8_SCHED;
            PG8_LDA(At, 0, 1); PG8_STAGE(PG8_SB(0, 0), b2, voffB); PG8_STAGE(PG8_SB(0, 1), b2 + hstep, voffB); PG8_STAGE(PG8_SA(0, 0), a2, voffA);
            PG8_WAIT_V(8); PG8_WAIT_L(0); PG8_BAR; PG8_MMA(1, 0, At, B0); PG8_MMA(1, 1, At, B1); PG8_BAR; PG8_SCHED;
            PG8_LDB(B0, 1, 0); PG8_LDB(B1, 1, 1); PG8_SCHED; PG8_LDA(At, 1, 0); PG8_STAGE(PG8_SA(0, 1), a2 + hstep, voffA);
            PG8_WAIT_V(8); PG8_WAIT_L(0); PG8_BAR; PG8_MMA(0, 0, At, B0); PG8_MMA(0, 1, At, B1); PG8_BAR; PG8_SCHED;
            PG8_LDA(At, 1, 1); PG8_STAGE(PG8_SB(1, 0), b3, voffB); PG8_STAGE(PG8_SB(1, 1), b3 + hstep, voffB); PG8_STAGE(PG8_SA(1, 0), a3, voffA);
            PG8_WAIT_V(8); PG8_WAIT_L(0); PG8_BAR; PG8_MMA(1, 0, At, B0); PG8_MMA(1, 1, At, B1); PG8_BAR; PG8_SCHED;
            } else {
            PG8_LDB(B0, 0, 0); PG8_SCHED; PG8_LDA(At, 0, 0); PG8_STAGE(PG8_SA(1, 1), a1 + hstep, voffA);
            PG8_WAIT_L(8); PG8_BAR; PG8_WAIT_L(0); PG8_MMA(0, 0, At, B0); PG8_BAR; PG8_SCHED;
            PG8_LDB(B1, 0, 1); PG8_STAGE(PG8_SB(0, 0), b2, voffB);
            PG8_BAR; PG8_WAIT_L(0); PG8_MMA(0, 1, At, B1); PG8_BAR;
            PG8_LDA(At, 0, 1); PG8_STAGE(PG8_SA(0, 0), a2, voffA);
            PG8_BAR; PG8_WAIT_L(0); PG8_MMA(1, 0, At, B0); PG8_BAR; PG8_SCHED;
            PG8_STAGE(PG8_SB(0, 1), b2 + hstep, voffB);
            PG8_WAIT_V(6); PG8_BAR; PG8_MMA(1, 1, At, B1); PG8_BAR;
            PG8_LDB(B0, 1, 0); PG8_SCHED; PG8_LDA(At, 1, 0); PG8_STAGE(PG8_SA(0, 1), a2 + hstep, voffA);
            PG8_WAIT_L(8); PG8_BAR; PG8_WAIT_L(0); PG8_MMA(0, 0, At, B0); PG8_BAR; PG8_SCHED;
            PG8_LDB(B1, 1, 1); PG8_STAGE(PG8_SB(1, 0), b3, voffB);
            PG8_BAR; PG8_WAIT_L(0); PG8_MMA(0, 1, At, B1); PG8_BAR;
            PG8_LDA(At, 1, 1); PG8_STAGE(PG8_SA(1, 0), a3, voffA);
            PG8_BAR; PG8_WAIT_L(0); PG8_MMA(1, 0, At, B0); PG8_BAR; PG8_SCHED;
            PG8_STAGE(PG8_SB(1, 1), b3 + hstep, voffB);
            PG8_WAIT_V(6); PG8_BAR; PG8_MMA(1, 1, At, B1); PG8_BAR;
            }
        }
        if constexpr (ALIGN_EPI) { if (wr == 0) PG8_BAR; }
        if constexpr (!Epi::AFTER_DRAIN) { E(acc, cur, wr, wc, fr, fq); S.done(cur); }
        if (!has_next) break;
#pragma unroll
        for (int a = 0; a < 2; ++a)
#pragma unroll
            for (int b = 0; b < 2; ++b)
#pragma unroll
                for (int m = 0; m < 4; ++m)
#pragma unroll
                    for (int n = 0; n < 2; ++n) acc[a][b][m][n] = (f32x4){0.f, 0.f, 0.f, 0.f};
        cur = nxt; cA = nA; cB = nB; ++ui;
        if constexpr (ALIGN_EPI) { if (wr == 1) PG8_BAR; }
    }
    PG8_WAIT_V(0);
    if constexpr (!ALIGN_EPI) { if (wr == 0) PG8_BAR; }
    PG8_BAR;
#undef PG8_SA
#undef PG8_SB
#undef PG8_STAGE
#undef PG8_LDA
#undef PG8_LDB
#undef PG8_MMA
#undef PG8_WAIT_V
#undef PG8_WAIT_L
#undef PG8_BAR
#undef PG8_SCHED
}
}
using pg8::cvt_pk_bf16;

#define LDS_WAIT() asm volatile("s_waitcnt lgkmcnt(0)" ::: "memory")
__device__ __forceinline__ float bf_lo(unsigned w) { return __uint_as_float(w << 16); }
__device__ __forceinline__ float bf_hi(unsigned w) { return __uint_as_float(w & 0xffff0000u); }
__device__ __forceinline__ float wave_sum(float v) {
#pragma unroll
    for (int o = 1; o < 64; o <<= 1) v += __shfl_xor(v, o);
    return v;
}
__device__ __forceinline__ float fast_exp2(float x) { return __builtin_amdgcn_exp2f(x); }
__device__ __forceinline__ float silu_f(float g) { return g / (1.0f + __expf(-g)); }
__device__ __forceinline__ float log_sigmoid_f(float d) { return d >= 0.f ? -log1pf(expf(-d)) : d - log1pf(expf(d)); }

__device__ __forceinline__ void sincos_acc(float ang, float& s, float& c) {
    const double a = (double)ang;
    const double kq = __builtin_rint(a * 0.63661977236758134308);
    double r = __builtin_fma(-kq, 1.57079632679489661923, a);
    r = __builtin_fma(-kq, 6.12323399573676603587e-17, r);
    const double r2 = r * r;
    const double sp = r * (1.0 + r2 * (-1.0 / 6 + r2 * (1.0 / 120 + r2 * (-1.0 / 5040 + r2 * (1.0 / 362880 + r2 * (-1.0 / 39916800))))));
    const double cp = 1.0 + r2 * (-0.5 + r2 * (1.0 / 24 + r2 * (-1.0 / 720 + r2 * (1.0 / 40320 + r2 * (-1.0 / 3628800 + r2 * (1.0 / 479001600))))));
    const int q = ((int)kq) & 3;
    const double ss = (q & 1) ? cp : sp, cc = (q & 1) ? sp : cp;
    s = (float)((q & 2) ? -ss : ss);
    c = (float)(((q + 1) & 2) ? -cc : cc);
}

constexpr int TPB = 272;
constexpr int TS = 128 * TPB;
constexpr int LDS_MISC = 4 * TS;
constexpr int LDS_BYTES = 143360;

typedef short v4i16_t __attribute__((ext_vector_type(4)));
__device__ __forceinline__ bf16x8 frag_row(LAS const unsigned char* tile, int row, int k) { return *(LAS const bf16x8*)(tile + row * TPB + k * 2); }
__device__ __forceinline__ bf16x8 frag_col(LAS const unsigned char* tile, int k0, int n0, int fr, int fq) {
    LAS const unsigned char* a = tile + (k0 + 8 * fq + (fr >> 2)) * TPB + (n0 + 4 * (fr & 3)) * 2;
    const s16x4 lo = __builtin_bit_cast(s16x4, __builtin_amdgcn_ds_read_tr16_b64_v4i16((LAS v4i16_t*)a));
    const s16x4 hi = __builtin_bit_cast(s16x4, __builtin_amdgcn_ds_read_tr16_b64_v4i16((LAS v4i16_t*)(a + 4 * TPB)));
    return (bf16x8){lo[0], lo[1], lo[2], lo[3], hi[0], hi[1], hi[2], hi[3]};
}
#define MFMA16(a, b, c) __builtin_amdgcn_mfma_f32_16x16x32_bf16((a), (b), (c), 0, 0, 0)
__device__ __forceinline__ void stage_tile(LAS unsigned char* dst, const bf16_t* src, size_t ld, int tid) {
    u32x4 v[4];
#pragma unroll
    for (int i = 0; i < 4; ++i) { const int c = tid + 512 * i; v[i] = *(const u32x4*)(src + (size_t)(c >> 4) * ld + (c & 15) * 8); }
#pragma unroll
    for (int i = 0; i < 4; ++i) { const int c = tid + 512 * i; *(LAS u32x4*)(dst + (c >> 4) * TPB + (c & 15) * 16) = v[i]; }
}

#define XB_TMO      128
#define XB_XCNT(j)  (256  + 64 * (j))
#define XB_XSUB(j)  (1280 + 64 * (j))
#define XB_XGEN(j)  (2304 + 64 * (j))
#define XB_TOP      3328
#define XB_TOPGEN   3392
#define XCD_BAR_WORDS 3456
#define XB_SPIN_CAP (1u << 18)
__device__ __forceinline__ unsigned xb_ld(unsigned* p)              { return __hip_atomic_load(p, __ATOMIC_RELAXED, __HIP_MEMORY_SCOPE_AGENT); }
__device__ __forceinline__ unsigned xb_add(unsigned* p, unsigned v) { return __hip_atomic_fetch_add(p, v, __ATOMIC_RELAXED, __HIP_MEMORY_SCOPE_AGENT); }
__device__ __forceinline__ unsigned xb_xcc_id() { return (unsigned)__builtin_amdgcn_s_getreg((3 << 11) | 20) & 0xFu; }
#define XB_SPIN(cond, bar) do { unsigned _sp = 0; while (cond) { __builtin_amdgcn_s_sleep(1); \
    if ((++_sp & 255u) == 0u) { if (xb_ld(&(bar)[XB_TMO])) break; if (_sp > XB_SPIN_CAP) { atomicAdd(&(bar)[XB_TMO], 1u); break; } } } } while (0)
struct XcdBarrier { unsigned* bar; unsigned x; volatile LAS unsigned* st; };
__device__ __forceinline__ XcdBarrier xcd_barrier_post(unsigned* bar, volatile LAS unsigned* st) {
    XcdBarrier b; b.bar = bar; b.x = xb_xcc_id(); b.st = st;
    if (threadIdx.x == 0) (void)xb_add(&bar[XB_XCNT(b.x)], 1u);
    return b;
}
__device__ __forceinline__ void xcd_barrier_complete(unsigned* bar, unsigned x, unsigned& nloc, unsigned& nx) {
    const unsigned G = gridDim.x * gridDim.y * gridDim.z;
    unsigned sum, cnt, mine, sp = 0u;
    for (;;) {
        sum = 0u; cnt = 0u; mine = 0u;
#pragma unroll
        for (unsigned j = 0; j < 16; ++j) { const unsigned c = xb_ld(&bar[XB_XCNT(j)]); sum += c; cnt += (c > 0u) ? 1u : 0u; mine = (j == x) ? c : mine; }
        if (sum == G) break;
        __builtin_amdgcn_s_sleep(1);
        if ((++sp & 255u) == 0u) { if (xb_ld(&bar[XB_TMO])) break; if (sp > XB_SPIN_CAP) { atomicAdd(&bar[XB_TMO], 1u); break; } }
    }
    nloc = mine > 0u ? mine : 1u; nx = cnt > 0u ? cnt : 1u;
}
__device__ __forceinline__ void xcd_barrier(const XcdBarrier& b) {
    asm volatile("s_waitcnt vmcnt(0)" ::: "memory");
    __syncthreads();
    if (threadIdx.x == 0) {
        unsigned* bar = b.bar;
        __builtin_amdgcn_s_waitcnt(0);
        unsigned nloc = b.st[0], nx = b.st[1];
        if (nloc == 0u) { xcd_barrier_complete(bar, b.x, nloc, nx); b.st[0] = nloc; b.st[1] = nx; }
        const unsigned old = xb_add(&bar[XB_XSUB(b.x)], 1u);
        const unsigned gen = old / nloc;
        if (old + 1u == (gen + 1u) * nloc) {
            __builtin_amdgcn_fence(__ATOMIC_RELEASE, "agent");
            asm volatile("s_waitcnt vmcnt(0)" ::: "memory");
            const unsigned og = xb_add(&bar[XB_TOP], 1u);
            const unsigned tg = og / nx;
            if (og + 1u == (tg + 1u) * nx) xb_add(&bar[XB_TOPGEN], 1u);
            else XB_SPIN(xb_ld(&bar[XB_TOPGEN]) == tg, bar);
            __builtin_amdgcn_fence(__ATOMIC_ACQUIRE, "agent");
            xb_add(&bar[XB_XGEN(b.x)], 1u);
            asm volatile("s_waitcnt vmcnt(0)" ::: "memory");
        } else {
            XB_SPIN(xb_ld(&bar[XB_XGEN(b.x)]) == gen, bar);
            __builtin_amdgcn_fence(__ATOMIC_ACQUIRE, "agent");
            asm volatile("s_waitcnt vmcnt(0)" ::: "memory");
        }
    }
    __syncthreads();
}

struct Params {
    const float *x, *w_in, *w_out, *norm_w, *dec_f, *dec_b, *gn_w, *gn_b, *sink, *fnw;
    float* out; unsigned char* ws;
};

__device__ __forceinline__ void p0_transpose_item(const float* W, const float* rowscale, int K, int N, bf16_t* WT, LAS float* scr, int item, int lane) {
    const int nblk = N / 32, kb = item / nblk, nb = item % nblk, k0 = 64 * kb, n0 = 32 * nb;
#pragma unroll
    for (int i = 0; i < 32; ++i) { const int kk = 2 * i + (lane >> 5); float v = W[(size_t)(k0 + kk) * N + n0 + (lane & 31)]; if (rowscale) v *= rowscale[k0 + kk]; scr[kk * 33 + (lane & 31)] = v; }
    LDS_WAIT();
    const int c = lane & 7;
#pragma unroll
    for (int j = 0; j < 4; ++j) { const int n = (lane >> 3) + 8 * j; const LAS float* s = scr + (8 * c) * 33 + n;
        u32x4 o; o.x = cvt_pk_bf16(s[0 * 33], s[1 * 33]); o.y = cvt_pk_bf16(s[2 * 33], s[3 * 33]); o.z = cvt_pk_bf16(s[4 * 33], s[5 * 33]); o.w = cvt_pk_bf16(s[6 * 33], s[7 * 33]);
        *(u32x4*)(WT + (size_t)(n0 + n) * K + k0 + 8 * c) = o; }
    LDS_WAIT();
}

__device__ __forceinline__ void scan_item(int item, const Params& p, LAS unsigned char* lds, int tid) {
    const int lane = tid & 63, wid = __builtin_amdgcn_readfirstlane(tid >> 6), fr = lane & 15, fq = lane >> 4;
    const int dir = item & 1, bh = item >> 1, b = bh >> 3, h = bh & 7;
    const float lg = log_sigmoid_f(dir ? p.dec_b[h] : p.dec_f[h]);
    const float cd = expf(lg * 128.0f);
    const bf16_t* proj = (const bf16_t*)(p.ws + WS_PROJ);
    const bf16_t* kbase = proj + (size_t)b * SEQ * NP + C_RK + h * 128;
    const bf16_t* vbase = proj + (size_t)b * SEQ * NP + C_RV + h * 128;
    bf16_t* sbase = (bf16_t*)(p.ws + WS_STATE) + ((size_t)(dir * 32 + bh) * NCH) * 16384;
    const int ch = tid & 15, rbase = tid >> 4;
    float dec[4];
#pragma unroll
    for (int i = 0; i < 4; ++i) { const int row = rbase + 32 * i; dec[i] = expf(lg * (float)(dir ? row : 127 - row)) * QK_SCALE; }
    f32x4 acc[8];
#pragma unroll
    for (int mt = 0; mt < 8; ++mt) acc[mt] = (f32x4){0.f, 0.f, 0.f, 0.f};
    u32x4 kr[4], vr[4];
    const int n0 = dir ? NCH - 1 : 0, stp = dir ? -1 : 1;
#define SCAN_GLOAD(n) do { const bf16_t* kp = kbase + (size_t)(n) * 128 * NP; const bf16_t* vp = vbase + (size_t)(n) * 128 * NP; \
    _Pragma("unroll") for (int i = 0; i < 4; ++i) { const size_t o = (size_t)(rbase + 32 * i) * NP + ch * 8; kr[i] = *(const u32x4*)(kp + o); vr[i] = *(const u32x4*)(vp + o); } } while (0)
#define SCAN_LWRITE(buf) do { LAS unsigned char* kt = lds + (buf) * TS; LAS unsigned char* vt = lds + (2 + (buf)) * TS; \
    _Pragma("unroll") for (int i = 0; i < 4; ++i) { const int o = (rbase + 32 * i) * TPB + ch * 16; const float d = dec[i]; u32x4 w; \
        w.x = cvt_pk_bf16(bf_lo(kr[i].x) * d, bf_hi(kr[i].x) * d); w.y = cvt_pk_bf16(bf_lo(kr[i].y) * d, bf_hi(kr[i].y) * d); \
        w.z = cvt_pk_bf16(bf_lo(kr[i].z) * d, bf_hi(kr[i].z) * d); w.w = cvt_pk_bf16(bf_lo(kr[i].w) * d, bf_hi(kr[i].w) * d); \
        *(LAS u32x4*)(kt + o) = w; *(LAS u32x4*)(vt + o) = vr[i]; } } while (0)
    __syncthreads();
    SCAN_GLOAD(n0); SCAN_LWRITE(0);
    __syncthreads();
    for (int s = 0; s < NCH; ++s) {
        const int n = n0 + s * stp;
        if (s + 1 < NCH) SCAN_GLOAD(n + stp);
        bf16_t* sp = sbase + (size_t)n * 16384 + (16 * wid + fr) * 128 + 4 * fq;
#pragma unroll
        for (int mt = 0; mt < 8; ++mt) { u32x2 w; w.x = cvt_pk_bf16(acc[mt][0], acc[mt][1]); w.y = cvt_pk_bf16(acc[mt][2], acc[mt][3]); *(u32x2*)(sp + 16 * mt) = w; acc[mt] = acc[mt] * cd; }
        LAS const unsigned char* kt = lds + (s & 1) * TS; LAS const unsigned char* vt = lds + (2 + (s & 1)) * TS;
#pragma unroll
        for (int ks = 0; ks < 4; ++ks) { const bf16x8 kf = frag_col(kt, 32 * ks, 16 * wid, fr, fq);
#pragma unroll
            for (int mt = 0; mt < 8; ++mt) acc[mt] = MFMA16(frag_col(vt, 32 * ks, 16 * mt, fr, fq), kf, acc[mt]); }
        if (s + 1 < NCH) SCAN_LWRITE((s + 1) & 1);
        __syncthreads();
    }
#undef SCAN_GLOAD
#undef SCAN_LWRITE
}

__device__ __forceinline__ void attn_item(int item, const Params& p, LAS unsigned char* lds, int tid) {
    const int lane = tid & 63, wid = __builtin_amdgcn_readfirstlane(tid >> 6), fr = lane & 15, fq = lane >> 4;
    const int g = item & 3, n = (item >> 2) & 31, kvh = (item >> 7) & 1, b = item >> 8, h = kvh * 4 + g;
    const bf16_t* proj = (const bf16_t*)(p.ws + WS_PROJ);
    const size_t tok0 = (size_t)b * SEQ + (size_t)n * 128;
    const bf16_t* qsrc = proj + tok0 * NP + C_AQ + h * 128;
    const bf16_t* ksrc = proj + tok0 * NP + C_AK + kvh * 128;
    const bf16_t* vsrc = proj + tok0 * NP + C_AV + kvh * 128;
    LAS unsigned char* R0 = lds; LAS unsigned char* R1 = lds + TS; LAS unsigned char* R2 = lds + 2 * TS; LAS unsigned char* R3 = lds + 3 * TS;
    const bool hasp = n > 0, hasn = n < NCH - 1;
    __syncthreads();
    stage_tile(R0, qsrc, NP, tid);
    if (hasp) stage_tile(R1, ksrc - (size_t)128 * NP, NP, tid);
    stage_tile(R2, ksrc, NP, tid);
    if (hasn) stage_tile(R3, ksrc + (size_t)128 * NP, NP, tid);
    __syncthreads();
    const int i0 = 16 * wid, iq = i0 + fr;
    bf16x8 qf[4];
#pragma unroll
    for (int ks = 0; ks < 4; ++ks) qf[ks] = frag_row(R0, iq, 32 * ks + 8 * fq);
    f32x4 S[3][8];
    const float NEG = -1e30f;
#pragma unroll
    for (int kb = 0; kb < 3; ++kb) {
        const bool valid = kb == 0 ? hasp : (kb == 2 ? hasn : true);
        LAS const unsigned char* kt = lds + (1 + kb) * TS;
        if (valid) {
#pragma unroll
            for (int jt = 0; jt < 8; ++jt) { f32x4 a = (f32x4){0.f, 0.f, 0.f, 0.f};
#pragma unroll
                for (int ks = 0; ks < 4; ++ks) a = MFMA16(frag_row(kt, 16 * jt + fr, 32 * ks + 8 * fq), qf[ks], a);
#pragma unroll
                for (int r = 0; r < 4; ++r) { const int j = 16 * jt + 4 * fq + r; float s = a[r] * QK_SCALE;
                    if (kb == 0 && j < iq) s = NEG;
                    if (kb == 2 && j > iq) s = NEG;
                    a[r] = s; }
                S[kb][jt] = a; }
        } else {
#pragma unroll
            for (int jt = 0; jt < 8; ++jt) S[kb][jt] = (f32x4){NEG, NEG, NEG, NEG};
        }
    }
    const float sk = p.sink[h];
    float mx = sk;
#pragma unroll
    for (int kb = 0; kb < 3; ++kb)
#pragma unroll
        for (int jt = 0; jt < 8; ++jt) mx = fmaxf(mx, fmaxf(fmaxf(S[kb][jt][0], S[kb][jt][1]), fmaxf(S[kb][jt][2], S[kb][jt][3])));
    mx = fmaxf(mx, __shfl_xor(mx, 16)); mx = fmaxf(mx, __shfl_xor(mx, 32));
    float l = 0.f;
#pragma unroll
    for (int kb = 0; kb < 3; ++kb)
#pragma unroll
        for (int jt = 0; jt < 8; ++jt) { f32x4 e;
#pragma unroll
            for (int r = 0; r < 4; ++r) { e[r] = fast_exp2((S[kb][jt][r] - mx) * LOG2E); l += e[r]; }
            S[kb][jt] = e; }
    l += __shfl_xor(l, 16); l += __shfl_xor(l, 32);
    l += fast_exp2((sk - mx) * LOG2E);
    const float inv = 1.0f / l;
    __syncthreads();
    if (hasp) stage_tile(R1, vsrc - (size_t)128 * NP, NP, tid);
    stage_tile(R2, vsrc, NP, tid);
    if (hasn) stage_tile(R3, vsrc + (size_t)128 * NP, NP, tid);
    __syncthreads();
    f32x4 O[8];
#pragma unroll
    for (int mt = 0; mt < 8; ++mt) O[mt] = (f32x4){0.f, 0.f, 0.f, 0.f};
#pragma unroll
    for (int kb = 0; kb < 3; ++kb) {
        const bool valid = kb == 0 ? hasp : (kb == 2 ? hasn : true);
        if (valid) {
            LAS const unsigned char* vt = lds + (1 + kb) * TS;
#pragma unroll
            for (int jt = 0; jt < 8; ++jt) { u32x2 w; w.x = cvt_pk_bf16(S[kb][jt][0], S[kb][jt][1]); w.y = cvt_pk_bf16(S[kb][jt][2], S[kb][jt][3]);
                *(LAS u32x2*)(R0 + iq * TPB + (16 * jt + 4 * fq) * 2) = w; }
            asm volatile("s_waitcnt lgkmcnt(0)" ::: "memory");
#pragma unroll
            for (int ks = 0; ks < 4; ++ks) { const bf16x8 pf = frag_row(R0, iq, 32 * ks + 8 * fq);
#pragma unroll
                for (int mt = 0; mt < 8; ++mt) O[mt] = MFMA16(frag_col(vt, 32 * ks, 16 * mt, fr, fq), pf, O[mt]); }
            asm volatile("s_waitcnt lgkmcnt(0)" ::: "memory");
        }
    }
    const size_t tok = tok0 + iq;
    const bf16_t* gp = proj + tok * NP + C_AG + h * 128 + 4 * fq;
    bf16_t* yp = (bf16_t*)(p.ws + WS_Y) + tok * DM + 1024 + h * 128 + 4 * fq;
#pragma unroll
    for (int mt = 0; mt < 8; ++mt) { const u32x2 gw = *(const u32x2*)(gp + 16 * mt);
        const float o0 = O[mt][0] * inv * silu_f(bf_lo(gw.x)), o1 = O[mt][1] * inv * silu_f(bf_hi(gw.x)), o2 = O[mt][2] * inv * silu_f(bf_lo(gw.y)), o3 = O[mt][3] * inv * silu_f(bf_hi(gw.y));
        u32x2 w; w.x = cvt_pk_bf16(o0, o1); w.y = cvt_pk_bf16(o2, o3); *(u32x2*)(yp + 16 * mt) = w; }
}

__device__ __forceinline__ void ret_item(int item, const Params& p, LAS unsigned char* lds, int tid) {
    const int lane = tid & 63, wid = __builtin_amdgcn_readfirstlane(tid >> 6), fr = lane & 15, fq = lane >> 4;
    const int n = item & 31, bh = item >> 5, b = bh >> 3, h = bh & 7;
    const bf16_t* proj = (const bf16_t*)(p.ws + WS_PROJ);
    const size_t tok0 = (size_t)b * SEQ + (size_t)n * 128;
    const bf16_t* qsrc = proj + tok0 * NP + C_RQ + h * 128;
    const bf16_t* ksrc = proj + tok0 * NP + C_RK + h * 128;
    const bf16_t* vsrc = proj + tok0 * NP + C_RV + h * 128;
    const bf16_t* sf = (const bf16_t*)(p.ws + WS_STATE) + ((size_t)(0 * 32 + bh) * NCH + n) * 16384;
    const bf16_t* sb = (const bf16_t*)(p.ws + WS_STATE) + ((size_t)(1 * 32 + bh) * NCH + n) * 16384;
    LAS unsigned char* R0 = lds; LAS unsigned char* R1 = lds + TS; LAS unsigned char* R2 = lds + 2 * TS; LAS unsigned char* R3 = lds + 3 * TS;
    const float lgf2 = log_sigmoid_f(p.dec_f[h]) * LOG2E, lgb2 = log_sigmoid_f(p.dec_b[h]) * LOG2E;
    __syncthreads();
    stage_tile(R0, qsrc, NP, tid); stage_tile(R1, ksrc, NP, tid); stage_tile(R2, vsrc, NP, tid); stage_tile(R3, sf, 128, tid);
    __syncthreads();
    const int i0 = 16 * wid, iq = i0 + fr;
    bf16x8 qf[4];
#pragma unroll
    for (int ks = 0; ks < 4; ++ks) qf[ks] = frag_row(R0, iq, 32 * ks + 8 * fq);
#pragma unroll
    for (int jt = 0; jt < 8; ++jt) { f32x4 a = (f32x4){0.f, 0.f, 0.f, 0.f};
#pragma unroll
        for (int ks = 0; ks < 4; ++ks) a = MFMA16(frag_row(R1, 16 * jt + fr, 32 * ks + 8 * fq), qf[ks], a);
#pragma unroll
        for (int r = 0; r < 4; ++r) { const int j = 16 * jt + 4 * fq + r; const int d = iq - j;
            const float e = d >= 0 ? lgf2 * (float)d : lgb2 * (float)(-d);
            a[r] = a[r] * (QK_SCALE * fast_exp2(e)); }
        u32x2 w; w.x = cvt_pk_bf16(a[0], a[1]); w.y = cvt_pk_bf16(a[2], a[3]);
        *(LAS u32x2*)(R0 + iq * TPB + (16 * jt + 4 * fq) * 2) = w; }
    asm volatile("s_waitcnt lgkmcnt(0)" ::: "memory");
    f32x4 O[8], Of[8], Ob[8];
#pragma unroll
    for (int mt = 0; mt < 8; ++mt) { O[mt] = (f32x4){0.f, 0.f, 0.f, 0.f}; Of[mt] = O[mt]; Ob[mt] = O[mt]; }
#pragma unroll
    for (int ks = 0; ks < 4; ++ks) { const bf16x8 pf = frag_row(R0, iq, 32 * ks + 8 * fq);
#pragma unroll
        for (int mt = 0; mt < 8; ++mt) { O[mt] = MFMA16(frag_col(R2, 32 * ks, 16 * mt, fr, fq), pf, O[mt]);
            Of[mt] = MFMA16(frag_col(R3, 32 * ks, 16 * mt, fr, fq), qf[ks], Of[mt]); } }
    __syncthreads();
    stage_tile(R3, sb, 128, tid);
    __syncthreads();
#pragma unroll
    for (int ks = 0; ks < 4; ++ks)
#pragma unroll
        for (int mt = 0; mt < 8; ++mt) Ob[mt] = MFMA16(frag_col(R3, 32 * ks, 16 * mt, fr, fq), qf[ks], Ob[mt]);
    const float rf = fast_exp2(lgf2 * (float)(iq + 1)), rb = fast_exp2(lgb2 * (float)(128 - iq));
    float sum = 0.f;
#pragma unroll
    for (int mt = 0; mt < 8; ++mt) { O[mt] = O[mt] + Of[mt] * rf + Ob[mt] * rb; sum += (O[mt][0] + O[mt][1]) + (O[mt][2] + O[mt][3]); }
    sum += __shfl_xor(sum, 16); sum += __shfl_xor(sum, 32);
    const float mu = sum * (1.0f / 128.0f);
    float var = 0.f;
#pragma unroll
    for (int mt = 0; mt < 8; ++mt) { O[mt] = O[mt] - mu; var += (O[mt][0] * O[mt][0] + O[mt][1] * O[mt][1]) + (O[mt][2] * O[mt][2] + O[mt][3] * O[mt][3]); }
    var += __shfl_xor(var, 16); var += __shfl_xor(var, 32);
    const float rs = 1.0f / sqrtf(var * (1.0f / 128.0f) + 1e-5f);
    const size_t tok = tok0 + iq;
    const bf16_t* gp = proj + tok * NP + C_RG + h * 128 + 4 * fq;
    const float* gw = p.gn_w + h * 128 + 4 * fq; const float* gb = p.gn_b + h * 128 + 4 * fq;
    bf16_t* yp = (bf16_t*)(p.ws + WS_Y) + tok * DM + h * 128 + 4 * fq;
#pragma unroll
    for (int mt = 0; mt < 8; ++mt) { const u32x2 gt = *(const u32x2*)(gp + 16 * mt); const f32x4 w4 = *(const f32x4*)(gw + 16 * mt), b4 = *(const f32x4*)(gb + 16 * mt);
        const float o0 = (O[mt][0] * rs * w4[0] + b4[0]) * silu_f(bf_lo(gt.x)), o1 = (O[mt][1] * rs * w4[1] + b4[1]) * silu_f(bf_hi(gt.x));
        const float o2 = (O[mt][2] * rs * w4[2] + b4[2]) * silu_f(bf_lo(gt.y)), o3 = (O[mt][3] * rs * w4[3] + b4[3]) * silu_f(bf_hi(gt.y));
        u32x2 w; w.x = cvt_pk_bf16(o0, o1); w.y = cvt_pk_bf16(o2, o3); *(u32x2*)(yp + 16 * mt) = w; }
}

__global__ void __launch_bounds__(512, 2) fwd_kernel(Params p) {
    extern __shared__ __attribute__((aligned(16))) unsigned char lds_raw[];
    LAS unsigned char* lds = (LAS unsigned char*)lds_raw;
    cg::grid_group grid = cg::this_grid();
    const int tid = threadIdx.x, lane = tid & 63, wave = __builtin_amdgcn_readfirstlane(tid >> 6);
    if (tid < 16) ((LAS unsigned*)(lds + LDS_MISC))[tid] = 0u;
    __syncthreads();
    XcdBarrier xbar = xcd_barrier_post((unsigned*)(p.ws + WS_CTL) + 1024, (volatile LAS unsigned*)(lds + LDS_MISC + 32));
    if (p.out == nullptr) grid.sync();
#define GRID_SYNC() xcd_barrier(xbar)
    const int G = gridDim.x, bid = blockIdx.x;
    const int gw = bid * 8 + wave, NGW = G * 8;
    const size_t gtid = (size_t)bid * 512 + tid, NT = (size_t)G * 512;
    unsigned char* ws = p.ws;
    unsigned* ctl = (unsigned*)(ws + WS_CTL);
    float* cosr = (float*)(ws + WS_COSR); float* sinr = (float*)(ws + WS_SINR); float* cosa = (float*)(ws + WS_COSA); float* sina = (float*)(ws + WS_SINA);
    float* rstd = (float*)(ws + WS_RSTD);
    bf16_t* win_t = (bf16_t*)(ws + WS_WIN); bf16_t* wout_t = (bf16_t*)(ws + WS_WOUT); bf16_t* xb = (bf16_t*)(ws + WS_XB);
    bf16_t* proj = (bf16_t*)(ws + WS_PROJ); bf16_t* yb = (bf16_t*)(ws + WS_Y);

    {
        LAS float* scr = (LAS float*)(lds + wave * 16384);
        constexpr int I_IN = (DM / 64) * (NP / 32), I_OUT = (DM / 64) * (DM / 32);
        for (int it = gw; it < I_IN + I_OUT; it += NGW) {
            if (it < I_IN) p0_transpose_item(p.w_in, p.norm_w, DM, NP, win_t, scr, it, lane);
            else p0_transpose_item(p.w_out, nullptr, DM, DM, wout_t, scr, it - I_IN, lane);
        }
        for (int m = gw; m < MTOK; m += NGW) {
            const f32x4* xr = (const f32x4*)(p.x + (size_t)m * DM) + lane;
            f32x4 v[8]; float s = 0.f;
#pragma unroll
            for (int j = 0; j < 8; ++j) { v[j] = xr[64 * j]; s += (v[j][0] * v[j][0] + v[j][1] * v[j][1]) + (v[j][2] * v[j][2] + v[j][3] * v[j][3]); }
            s = wave_sum(s);
            if (lane == 0) rstd[m] = 1.0f / sqrtf(s * (1.0f / DM) + 1e-6f);
            u32x2* o = (u32x2*)(xb + (size_t)m * DM) + lane;
#pragma unroll
            for (int j = 0; j < 8; ++j) { u32x2 w; w.x = cvt_pk_bf16(v[j][0], v[j][1]); w.y = cvt_pk_bf16(v[j][2], v[j][3]); o[64 * j] = w; }
        }
        for (size_t idx = gtid; idx < (size_t)SEQ * 64; idx += NT) { const int pos = (int)(idx >> 6), i = (int)(idx & 63);
            const float invf = powf(10000.0f, -(float)i / 64.0f); float s, c; sincos_acc((float)pos * invf, s, c); cosr[idx] = c; sinr[idx] = s; }
        for (size_t idx = gtid; idx < (size_t)SEQ * 16; idx += NT) { const int pos = (int)(idx >> 4), i = (int)(idx & 15);
            const float invf = powf(500000.0f, -(float)i / 16.0f); float s, c; sincos_acc((float)pos * invf, s, c); cosa[idx] = c; sina[idx] = s; }
    }
    GRID_SYNC();

    for (int rep = 0; rep < (PROBE_DUP == 1 ? 2 : 1); ++rep) {
        pg8::Gemm g{xb, win_t, MTOK, NP, DM}; pg8::StaticOrder S; S.init(MTOK, NP, G, bid);
        pg8::EpiProj E{proj, NP, rstd};
        pg8::gemm_phase<pg8::EpiProj, pg8::StaticOrder, true, true>(lds, g, S, E);
    }
    GRID_SYNC();

    {
        for (size_t idx = gtid; idx < (size_t)MTOK * 128; idx += NT) {
            const int t = (int)(idx >> 7), u = (int)(idx & 127), hd = u >> 3, gg = u & 7, pos = t & (SEQ - 1);
            bf16_t* p1 = proj + (size_t)t * NP + hd * 128 + 8 * gg; bf16_t* p2 = p1 + 64;
            const u32x4 a = *(const u32x4*)p1, bq = *(const u32x4*)p2;
            const float* cp = cosr + pos * 64 + 8 * gg; const float* sp = sinr + pos * 64 + 8 * gg;
            const f32x4 c0 = *(const f32x4*)cp, c1 = *(const f32x4*)(cp + 4), s0 = *(const f32x4*)sp, s1 = *(const f32x4*)(sp + 4);
            u32x4 o1, o2;
#define ROT2(W, CA, CB, SA, SB) { const float x1l = bf_lo(a.W), x1h = bf_hi(a.W), x2l = bf_lo(bq.W), x2h = bf_hi(bq.W); \
            o1.W = cvt_pk_bf16(x1l * (CA) - x2l * (SA), x1h * (CB) - x2h * (SB)); o2.W = cvt_pk_bf16(x2l * (CA) + x1l * (SA), x2h * (CB) + x1h * (SB)); }
            ROT2(x, c0[0], c0[1], s0[0], s0[1]) ROT2(y, c0[2], c0[3], s0[2], s0[3]) ROT2(z, c1[0], c1[1], s1[0], s1[1]) ROT2(w, c1[2], c1[3], s1[2], s1[3])
            *(u32x4*)p1 = o1; *(u32x4*)p2 = o2;
        }
        for (size_t idx = gtid; idx < (size_t)MTOK * 20; idx += NT) {
            const int t = (int)(idx / 20), u = (int)(idx % 20), pos = t & (SEQ - 1);
            const int hh = u >> 1, gg = u & 1;
            const int colb = hh < 8 ? C_AQ + hh * 128 : C_AK + (hh - 8) * 128;
            bf16_t* p1 = proj + (size_t)t * NP + colb + 8 * gg; bf16_t* p2 = p1 + 16;
            const u32x4 a = *(const u32x4*)p1, bq = *(const u32x4*)p2;
            const float* cp = cosa + pos * 16 + 8 * gg; const float* sp = sina + pos * 16 + 8 * gg;
            const f32x4 c0 = *(const f32x4*)cp, c1 = *(const f32x4*)(cp + 4), s0 = *(const f32x4*)sp, s1 = *(const f32x4*)(sp + 4);
            u32x4 o1, o2;
            ROT2(x, c0[0], c0[1], s0[0], s0[1]) ROT2(y, c0[2], c0[3], s0[2], s0[3]) ROT2(z, c1[0], c1[1], s1[0], s1[1]) ROT2(w, c1[2], c1[3], s1[2], s1[3])
#undef ROT2
            *(u32x4*)p1 = o1; *(u32x4*)p2 = o2;
        }
    }
    GRID_SYNC();

    for (int rep = 0; rep < (PROBE_DUP == 3 ? 2 : 1); ++rep) {
        LAS volatile int* slot = (LAS volatile int*)(lds + LDS_MISC);
        for (;;) {
            __syncthreads();
            if (tid == 0) *slot = (int)atomicAdd(ctl + rep, 1u);
            __syncthreads();
            const int item = *slot;
            if (item >= 64 + 1024) break;
            if (item < 64) scan_item(item, p, lds, tid);
            else attn_item(item - 64, p, lds, tid);
        }
    }
    GRID_SYNC();

    for (int rep = 0; rep < (PROBE_DUP == 4 ? 2 : 1); ++rep)
    for (int item = bid; item < 1024; item += G) ret_item(item, p, lds, tid);
    GRID_SYNC();

    {
        pg8::Gemm g{yb, wout_t, MTOK, DM, DM}; pg8::StaticOrder S; S.init(MTOK, DM, G, bid);
        pg8::EpiRes E{p.x, p.out, DM};
        pg8::gemm_phase<pg8::EpiRes, pg8::StaticOrder, true, true>(lds, g, S, E);
    }
    GRID_SYNC();

    if (PROBE_DUP == 9) { GRID_SYNC(); GRID_SYNC(); GRID_SYNC(); GRID_SYNC(); GRID_SYNC(); GRID_SYNC(); }
    for (int m = gw; m < MTOK; m += NGW) {
        f32x4* xr = (f32x4*)(p.out + (size_t)m * DM) + lane;
        const f32x4* wr4 = (const f32x4*)p.fnw + lane;
        f32x4 v[8]; float s = 0.f;
#pragma unroll
        for (int j = 0; j < 8; ++j) { v[j] = xr[64 * j]; s += (v[j][0] * v[j][0] + v[j][1] * v[j][1]) + (v[j][2] * v[j][2] + v[j][3] * v[j][3]); }
        s = wave_sum(s);
        const float rs = 1.0f / sqrtf(s * (1.0f / DM) + 1e-6f);
#pragma unroll
        for (int j = 0; j < 8; ++j) xr[64 * j] = v[j] * rs * wr4[64 * j];
    }
}

extern "C" void kernel_launch(void* const* d_in, const int* in_sizes, int n_in, void* d_out, int out_size, void* d_ws, size_t ws_size, hipStream_t stream) {
    static int grid = 0;
    if (grid == 0) {
        if (n_in != 10 || in_sizes[0] != MTOK * DM || out_size != MTOK * DM || ws_size < WS_END) {
            fprintf(stderr, "kernel_launch: unexpected shapes (n_in %d, in0 %d, out %d, ws %zu)\n", n_in, n_in > 0 ? in_sizes[0] : -1, out_size, ws_size); grid = -1; return; }
        int dev = 0, cus = 0, per_cu = 0;
        hipGetDevice(&dev);
        hipDeviceGetAttribute(&cus, hipDeviceAttributeMultiprocessorCount, dev);
        hipFuncSetAttribute((const void*)fwd_kernel, hipFuncAttributeMaxDynamicSharedMemorySize, LDS_BYTES);
        hipOccupancyMaxActiveBlocksPerMultiprocessor(&per_cu, (const void*)fwd_kernel, 512, LDS_BYTES);
        if (per_cu < 1) { fprintf(stderr, "kernel_launch: occupancy query says %d blocks per CU\n", per_cu); per_cu = 1; }
        (void)hipGetLastError();
        grid = cus * per_cu;
    }
    if (grid < 0) return;
    Params p{};
    p.x = (const float*)d_in[0]; p.w_in = (const float*)d_in[1]; p.w_out = (const float*)d_in[2]; p.norm_w = (const float*)d_in[3];
    p.dec_f = (const float*)d_in[4]; p.dec_b = (const float*)d_in[5]; p.gn_w = (const float*)d_in[6]; p.gn_b = (const float*)d_in[7];
    p.sink = (const float*)d_in[8]; p.fnw = (const float*)d_in[9];
    p.out = (float*)d_out; p.ws = (unsigned char*)d_ws;
    if (hipMemsetAsync((char*)d_ws + WS_CTL, 0, 65536, stream) != hipSuccess) { fprintf(stderr, "kernel_launch: memset failed\n"); return; }
    void* args[] = {&p};
    hipError_t e = hipLaunchCooperativeKernel((const void*)fwd_kernel, dim3(grid), dim3(512), args, LDS_BYTES, stream);
    if (e != hipSuccess) fprintf(stderr, "kernel_launch: cooperative launch failed: %s (grid %d)\n", hipGetErrorString(e), grid);
}
```
